# Optimizing an MI355X kernel written in HIP

```python
import jax, jax.numpy as jnp
from jax import lax
import numpy as np

D_MODEL = 1024
BATCH = 32
SEQ = 2048
DEPTH = 2

HG_HEADS = 4
HG_DIM = 128
HG_WIDTH = HG_HEADS * HG_DIM
HG_CHUNK = 64
NSA_HEADS = 8
NSA_KV_HEADS = 2
NSA_GROUP = NSA_HEADS // NSA_KV_HEADS
NSA_DIM = 64
NSA_WIDTH = NSA_HEADS * NSA_DIM
NSA_KV_WIDTH = NSA_KV_HEADS * NSA_DIM
CMP_LEN = 32
CMP_STRIDE = 16
CMP_HIDDEN = 256
SLC_LEN = 64
SLC_TOP = 16
SLC_QBLOCK = 32
WINDOW = 512
SWA_QBLOCK = 128
N_BRANCH = 3
MIX_WIDTH = HG_WIDTH + NSA_WIDTH
D_FF = ((8 * D_MODEL + 3 * 256 - 1) // (3 * 256)) * 256
ROPE_THETA = 10000.0
RMS_EPS = 1e-6
NEG = -1e30
FORCED_SCORE = 1e9
IN_SPLITS = (HG_WIDTH, HG_WIDTH, HG_WIDTH, HG_WIDTH, NSA_WIDTH,
             NSA_KV_WIDTH, NSA_KV_WIDTH, NSA_KV_WIDTH, NSA_KV_WIDTH, NSA_KV_WIDTH, NSA_KV_WIDTH,
             NSA_HEADS * N_BRANCH)
IN_WIDTH = sum(IN_SPLITS)
IN_SPLIT_POINTS = tuple(int(v) for v in np.cumsum(IN_SPLITS)[:-1])

kernel_name = 'hymba_hgrn2_nsa_swiglu_trunk'


def rms_norm(x, gain):
    xf = x.astype(jnp.float32)
    y = xf * lax.rsqrt(jnp.mean(xf * xf, axis=-1, keepdims=True) + RMS_EPS)
    return (y * gain.astype(jnp.float32)).astype(x.dtype)


def rope(x, pos):
    half = x.shape[-1] // 2
    freqs = ROPE_THETA ** (-jnp.arange(half, dtype=jnp.float32) / half)
    ang = pos.astype(jnp.float32)[:, None] * freqs[None, :]
    cos = jnp.cos(ang)[:, None, :]
    sin = jnp.sin(ang)[:, None, :]
    xf = x.astype(jnp.float32)
    x1, x2 = xf[..., :half], xf[..., half:]
    return jnp.concatenate([x1 * cos - x2 * sin, x1 * sin + x2 * cos], axis=-1).astype(x.dtype)


def hgrn2_mixer(q, f_logit, i, g, lower_bound, g_norm):
    B, T, _ = q.shape
    dt = q.dtype
    n_chunk = T // HG_CHUNK
    lb = lower_bound.astype(jnp.float32)
    f = lb + (1.0 - lb) * jax.nn.sigmoid(f_logit.astype(jnp.float32))
    log_f = jnp.log(f)
    k = 1.0 - f
    qf = jax.nn.silu(q.astype(jnp.float32))
    v = i.astype(jnp.float32)

    def to_chunks(a):
        return a.reshape(B, n_chunk, HG_CHUNK, HG_HEADS, HG_DIM).transpose(1, 0, 3, 2, 4)

    causal = jnp.tril(jnp.ones((HG_CHUNK, HG_CHUNK), dtype=bool))[:, :, None]

    def step(S, xs):
        qc, kc, vc, lfc = xs
        b = jnp.cumsum(lfc, axis=2)
        diff = b[:, :, :, None, :] - b[:, :, None, :, :]
        decay = jnp.exp(jnp.where(causal, diff, -jnp.inf))
        A = jnp.einsum('bhtd,bhsd,bhtsd->bhts', qc, kc, decay)
        o = (jnp.einsum('bhts,bhsv->bhtv', A, vc)
             + jnp.einsum('bhtd,bhdv->bhtv', qc * jnp.exp(b), S))
        b_last = b[:, :, -1:, :]
        S = (jnp.exp(b_last[:, :, 0, :])[..., None] * S
             + jnp.einsum('bhsd,bhsv->bhdv', kc * jnp.exp(b_last - b), vc))
        return S, o

    S0 = jnp.zeros((B, HG_HEADS, HG_DIM, HG_DIM), jnp.float32)
    _, o = lax.scan(step, S0, (to_chunks(qf), to_chunks(k), to_chunks(v), to_chunks(log_f)))
    o = o.transpose(1, 0, 3, 2, 4).reshape(B, T, HG_HEADS, HG_DIM)
    o = rms_norm(o, g_norm) * jax.nn.silu(g.astype(jnp.float32).reshape(B, T, HG_HEADS, HG_DIM))
    return o.reshape(B, T, HG_WIDTH).astype(dt)


def compress(a, pe, w1, w2):
    B, T, G, d = a.shape
    R = CMP_LEN // CMP_STRIDE
    n_cmp = (T - CMP_LEN) // CMP_STRIDE + 1
    seg = a.reshape(B, T // CMP_STRIDE, CMP_STRIDE, G, d)
    blocks = jnp.concatenate([seg[:, r:r + n_cmp] for r in range(R)], axis=2)
    blocks = blocks + pe[None, None, :, None, :]
    flat = blocks.transpose(0, 1, 3, 2, 4).reshape(B, n_cmp, G, CMP_LEN * d)
    return jax.nn.silu(flat @ w1) @ w2


def cmp_to_slc_matrix(T):
    n_cmp = (T - CMP_LEN) // CMP_STRIDE + 1
    n_slc = T // SLC_LEN
    c_start = np.arange(n_cmp) * CMP_STRIDE
    c_end = c_start + CMP_LEN - 1
    s_start = np.arange(n_slc) * SLC_LEN
    s_end = s_start + SLC_LEN - 1
    M = (c_start[:, None] <= s_end[None, :]) & (c_end[:, None] >= s_start[None, :])
    return jnp.asarray(M.astype(np.float32))


def nsa_mixer(q, k_cmp, v_cmp, k_slc, v_slc, k_swa, v_swa, gate_logit, q_gain, k_gain,
              pe_k, w1_k, w2_k, pe_v, w1_v, w2_v):
    B, T, _ = q.shape
    dt = q.dtype
    H, G, Hg, d = NSA_HEADS, NSA_KV_HEADS, NSA_GROUP, NSA_DIM
    pos = jnp.arange(T)
    scale = d ** -0.5
    qr = rope(rms_norm(q.reshape(B, T, H, d), q_gain), pos)
    qg = qr.reshape(B, T, G, Hg, d)

    def kv_heads(a):
        return a.reshape(B, T, G, d)

    kc = compress(kv_heads(k_cmp), pe_k, w1_k, w2_k)
    vc = compress(kv_heads(v_cmp), pe_v, w1_v, w2_v)
    n_cmp = kc.shape[1]
    cmp_end = jnp.arange(n_cmp) * CMP_STRIDE + CMP_LEN - 1
    kc = rope(rms_norm(kc, k_gain[0]), cmp_end)
    s = jnp.einsum('btghd,bngd->bghtn', qg, kc).astype(jnp.float32) * scale
    m_cmp = cmp_end[None, :] <= pos[:, None]
    p_cmp = jax.nn.softmax(jnp.where(m_cmp, s, NEG), axis=-1) * m_cmp
    o_cmp = jnp.einsum('bghtn,bngd->btghd', p_cmp.astype(dt), vc)

    n_slc = T // SLC_LEN
    imp = jnp.einsum('bghtn,nj->bgtj', p_cmp, cmp_to_slc_matrix(T))
    blk = jnp.arange(n_slc)
    cur = pos // SLC_LEN
    forced = (blk[None, :] == 0) | (blk[None, :] == cur[:, None]) | (blk[None, :] == cur[:, None] - 1)
    causal_blk = blk[None, :] <= cur[:, None]
    score = jnp.where(forced, FORCED_SCORE, jnp.where(causal_blk, imp, NEG))
    top = min(SLC_TOP, n_slc)
    _, idx = lax.top_k(score, top)

    ks = rope(rms_norm(kv_heads(k_slc), k_gain[1]), pos)
    kb = ks.reshape(B, n_slc, SLC_LEN, G, d).transpose(0, 3, 1, 2, 4)
    vb = kv_heads(v_slc).reshape(B, n_slc, SLC_LEN, G, d).transpose(0, 3, 1, 2, 4)
    nq = T // SLC_QBLOCK
    q_blocks = qg.reshape(B, nq, SLC_QBLOCK, G, Hg, d).transpose(1, 0, 3, 4, 2, 5)
    idx_blocks = idx.reshape(B, G, nq, SLC_QBLOCK, top).transpose(2, 0, 1, 3, 4)
    t_blocks = pos.reshape(nq, SLC_QBLOCK)
    bi = jnp.arange(B)[:, None, None, None]
    gi = jnp.arange(G)[None, :, None, None]
    tok = jnp.arange(SLC_LEN)

    def slc_block(xs):
        qb, ib, tb = xs
        kg = kb[bi, gi, ib]
        vg = vb[bi, gi, ib]
        sb = jnp.einsum('bghqd,bgqnsd->bghqns', qb, kg).astype(jnp.float32) * scale
        kpos = ib[..., None] * SLC_LEN + tok
        mb = (kpos <= tb[None, None, :, None, None])[:, :, None]
        sb = jnp.where(mb, sb, NEG)
        pb = jax.nn.softmax(sb.reshape(B, G, Hg, SLC_QBLOCK, -1), axis=-1).reshape(sb.shape)
        return jnp.einsum('bghqns,bgqnsd->bghqd', pb.astype(dt), vg)

    o_slc = lax.map(slc_block, (q_blocks, idx_blocks, t_blocks))
    o_slc = o_slc.transpose(1, 0, 4, 2, 3, 5).reshape(B, T, G, Hg, d)

    kw = rope(rms_norm(kv_heads(k_swa), k_gain[2]), pos)
    vw = kv_heads(v_swa)
    kpad = jnp.pad(kw, ((0, 0), (WINDOW, 0), (0, 0), (0, 0)))
    vpad = jnp.pad(vw, ((0, 0), (WINDOW, 0), (0, 0), (0, 0)))
    nw = T // SWA_QBLOCK
    span = WINDOW + SWA_QBLOCK
    qw_blocks = qg.reshape(B, nw, SWA_QBLOCK, G, Hg, d).transpose(1, 0, 3, 4, 2, 5)

    def swa_block(xs):
        qb, n = xs
        start = n * SWA_QBLOCK
        kblk = lax.dynamic_slice_in_dim(kpad, start, span, axis=1)
        vblk = lax.dynamic_slice_in_dim(vpad, start, span, axis=1)
        tq = start + jnp.arange(SWA_QBLOCK)
        tk = start - WINDOW + jnp.arange(span)
        mw = (tk[None, :] <= tq[:, None]) & (tk[None, :] > tq[:, None] - WINDOW) & (tk[None, :] >= 0)
        sw = jnp.einsum('bghqd,bkgd->bghqk', qb, kblk).astype(jnp.float32) * scale
        pw = jax.nn.softmax(jnp.where(mw, sw, NEG), axis=-1)
        return jnp.einsum('bghqk,bkgd->bghqd', pw.astype(dt), vblk)

    o_swa = lax.map(swa_block, (qw_blocks, jnp.arange(nw)))
    o_swa = o_swa.transpose(1, 0, 4, 2, 3, 5).reshape(B, T, G, Hg, d)

    gate = jax.nn.sigmoid(gate_logit.astype(jnp.float32)).reshape(B, T, G, Hg, N_BRANCH)
    o = (gate[..., 0:1] * o_cmp.astype(jnp.float32)
         + gate[..., 1:2] * o_slc.astype(jnp.float32)
         + gate[..., 2:3] * o_swa.astype(jnp.float32))
    return o.reshape(B, T, NSA_WIDTH).astype(dt)


def setup_inputs(seed: int = 0) -> dict:
    key = jax.random.key(seed)
    ks = jax.random.split(key, 20)

    def dense(k, shape, fan_in):
        return jax.random.normal(k, shape, jnp.float32) * fan_in ** -0.5

    def gain(k, shape):
        return 1.0 + 0.05 * jax.random.normal(k, shape, jnp.float32)

    return {
        'x': jax.random.normal(ks[0], (BATCH, SEQ, D_MODEL), jnp.float32),
        'w_in': dense(ks[1], (DEPTH, D_MODEL, IN_WIDTH), D_MODEL),
        'w_out': dense(ks[2], (DEPTH, MIX_WIDTH, D_MODEL), MIX_WIDTH),
        'hg_lb_logits': 0.1 * jax.random.normal(ks[3], (DEPTH, HG_WIDTH), jnp.float32),
        'hg_gnorm': gain(ks[4], (DEPTH, HG_DIM)),
        'q_gain': gain(ks[5], (DEPTH, NSA_DIM)),
        'k_gain': gain(ks[6], (DEPTH, N_BRANCH, NSA_DIM)),
        'cmp_pe_k': 0.1 * jax.random.normal(ks[7], (DEPTH, CMP_LEN, NSA_DIM), jnp.float32),
        'cmp_w1_k': dense(ks[8], (DEPTH, CMP_LEN * NSA_DIM, CMP_HIDDEN), CMP_LEN * NSA_DIM),
        'cmp_w2_k': dense(ks[9], (DEPTH, CMP_HIDDEN, NSA_DIM), CMP_HIDDEN),
        'cmp_pe_v': 0.1 * jax.random.normal(ks[10], (DEPTH, CMP_LEN, NSA_DIM), jnp.float32),
        'cmp_w1_v': dense(ks[11], (DEPTH, CMP_LEN * NSA_DIM, CMP_HIDDEN), CMP_LEN * NSA_DIM),
        'cmp_w2_v': dense(ks[12], (DEPTH, CMP_HIDDEN, NSA_DIM), CMP_HIDDEN),
        'w_ffn_in': dense(ks[13], (DEPTH, D_MODEL, 2 * D_FF), D_MODEL),
        'w_ffn_out': dense(ks[14], (DEPTH, D_FF, D_MODEL), D_FF),
        'norm_mix': gain(ks[15], (DEPTH, D_MODEL)),
        'norm_ffn': gain(ks[16], (DEPTH, D_MODEL)),
    }


def reference(x, w_in, w_out, hg_lb_logits, hg_gnorm, q_gain, k_gain,
              cmp_pe_k, cmp_w1_k, cmp_w2_k, cmp_pe_v, cmp_w1_v, cmp_w2_v,
              w_ffn_in, w_ffn_out, norm_mix, norm_ffn):
    lb = jnp.cumsum(jax.nn.softmax(hg_lb_logits.astype(jnp.float32), axis=0), axis=0)
    lb = lb - lb[0:1]
    h = x
    for l in range(DEPTH):
        xn = rms_norm(h, norm_mix[l])
        proj = xn @ w_in[l]
        (hq, hf, hi, hg, nq, kc, vc, ksl, vsl, ksw, vsw, ngate) = jnp.split(proj, IN_SPLIT_POINTS, axis=-1)
        o_hg = hgrn2_mixer(hq, hf, hi, hg, lb[l], hg_gnorm[l])
        o_nsa = nsa_mixer(nq, kc, vc, ksl, vsl, ksw, vsw, ngate, q_gain[l], k_gain[l],
                          cmp_pe_k[l], cmp_w1_k[l], cmp_w2_k[l], cmp_pe_v[l], cmp_w1_v[l], cmp_w2_v[l])
        mix = jnp.concatenate([o_hg, o_nsa], axis=-1)
        h = h + mix @ w_out[l]
        xn = rms_norm(h, norm_ffn[l])
        gu = xn @ w_ffn_in[l]
        g_ff, u_ff = gu[..., :D_FF], gu[..., D_FF:]
        h = h + (jax.nn.silu(g_ff) * u_ff) @ w_ffn_out[l]
    return h
```

```cpp
#include <hip/hip_runtime.h>
#include <hip/hip_cooperative_groups.h>
#include <cstdio>
#include <cstdint>
namespace cg = cooperative_groups;
namespace pg8 {
#define PG8_LAS __attribute__((address_space(3)))
typedef unsigned short bf16_t;
typedef short bf16x8 __attribute__((ext_vector_type(8)));
typedef float f32x4 __attribute__((ext_vector_type(4)));
typedef unsigned u32x4 __attribute__((ext_vector_type(4)));
constexpr int BM = 256, BK = 64, HALF = 128, HTB = HALF * BK * 2  , STAGE_BYTES = 8 * HTB, NXCD = 8, WGM = 8;

__host__ __device__ __forceinline__ int lds_byte(int r, int c) { const int st = (r >> 4) * 2 + (c >> 5), rr = r & 15, cc = c & 31, ob = rr * 64 + cc * 2; return st * 1024 + (ob ^ (((ob >> 9) & 1) << 5)); }
__host__ __device__ __forceinline__ void stage_rc(int b, int& R, int& C) { const int st = b / 1024, sb = b % 1024, swz = sb ^ (((sb >> 9) & 1) << 5); R = (st >> 1) * 16 + swz / 64; C = (st & 1) * 32 + (swz % 64) / 2; }
__host__ __device__ __forceinline__ int perm32(int rho) { const int n = rho >> 4, i = rho & 15; return 8 * (i >> 2) + 4 * n + (i & 3); }

struct Unit { int pm, pn; };
struct Gemm { const bf16_t* A; const bf16_t* Bt; int M, N, K; };

struct StaticOrder {
    int nM, nN, nwg, G, c;
    __host__ __device__ void init(int M, int N, int G_, int c_) { nM = M / BM; nN = N / BM; nwg = nM * nN; G = G_; c = c_; }
    __host__ __device__ bool next(int i, Unit& u) const {
        const long L = (long)i * G + c; if (L >= nwg) return false;
        int wgid = (int)L; { const int q = nwg / NXCD, r = nwg % NXCD, xcd = wgid % NXCD, off = wgid / NXCD; wgid = (xcd < r ? xcd * (q + 1) : r * (q + 1) + (xcd - r) * q) + off; }
        const int nig = WGM * nN, gid = wgid / nig, fm = gid * WGM, gsz = (nM - fm) < WGM ? (nM - fm) : WGM;
        u.pm = fm + ((wgid % nig) % gsz); u.pn = (wgid % nig) / gsz; return true;
    }
    __device__ __forceinline__ void a_ready(const Unit&) const {}
    __device__ __forceinline__ void done(const Unit&) const {}
};

__device__ __forceinline__ unsigned cvt_pk_bf16(float lo, float hi) { unsigned r; asm volatile("v_cvt_pk_bf16_f32 %0, %1, %2" : "=v"(r) : "v"(lo), "v"(hi)); return r; }
typedef float f32x2 __attribute__((ext_vector_type(2)));
template <class Epi, class Sched, bool ALIGN_EPI = false, bool SP2 = false>
__device__ __forceinline__ void gemm_phase(PG8_LAS unsigned char* lds, const Gemm g, const Sched& S, const Epi& E, const int tid) {
    const int wid = __builtin_amdgcn_readfirstlane(tid >> 6), lane = tid & 63, wr = wid >> 2, wc = wid & 3, fr = lane & 15, fq = lane >> 4;
    const int K = g.K, nt = K / BK;
    unsigned voffA[2], voffB[2];
#pragma unroll
    for (int i = 0; i < 2; ++i) { int R, C; stage_rc(tid * 16 + i * 8192, R, C); const int Rb = Epi::PERM ? ((R & ~31) + perm32(R & 31)) : R;
        voffA[i] = (unsigned)(R * K + C) * 2u; voffB[i] = (unsigned)(Rb * K + C) * 2u; }
    const size_t kstep = (size_t)(BK * 2);
    const size_t hstep = (size_t)HALF * K * 2;
    const size_t tstep = 2 * hstep;
    const unsigned ldsw = (unsigned)wid * 1024u;
    const int aoff = lds_byte(wr * 64 + fr, fq * 8), boff = lds_byte(wc * 32 + fr, fq * 8);
#define PG8_SA(b, h) (((b) * 2 + (h)) * HTB)
#define PG8_SB(b, h) ((4 + (b) * 2 + (h)) * HTB)
#define PG8_STAGE(bufoff, gbase, voff) do { _Pragma("unroll") for (int _i = 0; _i < 2; ++_i) \
        __builtin_amdgcn_global_load_lds((const unsigned*)((const char*)(gbase) + (voff)[_i]), (PG8_LAS unsigned*)(lds + (bufoff) + ldsw + _i * 8192), 16, 0, 0); } while (0)
#define PG8_LDA(dst, b, h) do { _Pragma("unroll") for (int m = 0; m < 4; ++m) _Pragma("unroll") for (int k = 0; k < 2; ++k) dst[m][k] = *(const PG8_LAS bf16x8*)(lds + PG8_SA(b, h) + aoff + m * 2048 + k * 1024); } while (0)
#define PG8_LDB(dst, b, h) do { _Pragma("unroll") for (int n = 0; n < 2; ++n) _Pragma("unroll") for (int k = 0; k < 2; ++k) dst[n][k] = *(const PG8_LAS bf16x8*)(lds + PG8_SB(b, h) + boff + n * 2048 + k * 1024); } while (0)
#define PG8_MMA(ai, bj, At, Bt) do { __builtin_amdgcn_s_setprio(1); _Pragma("unroll") for (int m = 0; m < 4; ++m) _Pragma("unroll") for (int n = 0; n < 2; ++n) _Pragma("unroll") for (int k = 0; k < 2; ++k) \
        acc[ai][bj][m][n] = __builtin_amdgcn_mfma_f32_16x16x32_bf16(Bt[n][k], At[m][k], acc[ai][bj][m][n], 0, 0, 0); __builtin_amdgcn_s_setprio(0); } while (0)
#define PG8_WAIT_V(n) asm volatile("s_waitcnt vmcnt(" #n ")" ::: "memory")
#define PG8_WAIT_L(n) asm volatile("s_waitcnt lgkmcnt(" #n ")" ::: "memory")
#define PG8_BAR __builtin_amdgcn_s_barrier()
#define PG8_SCHED __builtin_amdgcn_sched_barrier(0)
    Unit cur, nxt; int ui = 0;
    if (!S.next(0, cur)) return;
    f32x4 acc[2][2][4][2];
#pragma unroll
    for (int a = 0; a < 2; ++a)
#pragma unroll
        for (int b = 0; b < 2; ++b)
#pragma unroll
            for (int m = 0; m < 4; ++m)
#pragma unroll
                for (int n = 0; n < 2; ++n) acc[a][b][m][n] = (f32x4){0.f, 0.f, 0.f, 0.f};
    bf16x8 At[4][2], B0[2][2], B1[2][2];
    const char* cA = (const char*)g.A + (size_t)cur.pm * tstep; const char* cB = (const char*)g.Bt + (size_t)cur.pn * tstep;
    S.a_ready(cur);
    if constexpr (SP2) {
        PG8_STAGE(PG8_SB(0, 0), cB, voffB); PG8_STAGE(PG8_SB(0, 1), cB + hstep, voffB); PG8_STAGE(PG8_SA(0, 0), cA, voffA); PG8_STAGE(PG8_SA(0, 1), cA + hstep, voffA);
        if (wr == 1) PG8_BAR;
        PG8_WAIT_V(2); PG8_BAR;
        PG8_STAGE(PG8_SB(1, 0), cB + kstep, voffB); PG8_STAGE(PG8_SA(1, 0), cA + kstep, voffA); PG8_STAGE(PG8_SB(1, 1), cB + hstep + kstep, voffB);
        PG8_WAIT_V(6); PG8_BAR;
    } else {
        PG8_STAGE(PG8_SB(0, 0), cB, voffB); PG8_STAGE(PG8_SA(0, 0), cA, voffA); PG8_STAGE(PG8_SB(0, 1), cB + hstep, voffB); PG8_STAGE(PG8_SA(0, 1), cA + hstep, voffA);
        if (wr == 1) PG8_BAR;
        PG8_WAIT_V(4); PG8_BAR;
        PG8_STAGE(PG8_SB(1, 0), cB + kstep, voffB); PG8_STAGE(PG8_SA(1, 0), cA + kstep, voffA); PG8_STAGE(PG8_SB(1, 1), cB + hstep + kstep, voffB);
        PG8_WAIT_V(6); PG8_BAR;
    }
    for (;;) {
        const bool has_next = S.next(ui + 1, nxt);
        const char* nA = has_next ? (const char*)g.A + (size_t)nxt.pm * tstep : cA; const char* nB = has_next ? (const char*)g.Bt + (size_t)nxt.pn * tstep : cB;
        for (int t = 0; t < nt; t += 2) {
            const bool last = (t == nt - 2);
            const char* a1 = cA + (size_t)(t + 1) * kstep;
            const char* a2 = last ? nA : cA + (size_t)(t + 2) * kstep; const char* b2 = last ? nB : cB + (size_t)(t + 2) * kstep;
            const char* a3 = a2 + kstep; const char* b3 = b2 + kstep;
            if (last && has_next) S.a_ready(nxt);
            if constexpr (SP2) {
            PG8_LDB(B0, 0, 0); PG8_LDB(B1, 0, 1); PG8_SCHED; PG8_LDA(At, 0, 0); PG8_STAGE(PG8_SA(1, 1), a1 + hstep, voffA);
            PG8_WAIT_V(8); PG8_WAIT_L(0); PG8_BAR; PG8_MMA(0, 0, At, B0); PG8_MMA(0, 1, At, B1); PG8_BAR; PG8_SCHED;
            PG8_LDA(At, 0, 1); PG8_STAGE(PG8_SB(0, 0), b2, voffB); PG8_STAGE(PG8_SB(0, 1), b2 + hstep, voffB); PG8_STAGE(PG8_SA(0, 0), a2, voffA);
            PG8_WAIT_V(8); PG8_WAIT_L(0); PG8_BAR; PG8_MMA(1, 0, At, B0); PG8_MMA(1, 1, At, B1); PG8_BAR; PG8_SCHED;
            PG8_LDB(B0, 1, 0); PG8_LDB(B1, 1, 1); PG8_SCHED; PG8_LDA(At, 1, 0); PG8_STAGE(PG8_SA(0, 1), a2 + hstep, voffA);
            PG8_WAIT_V(8); PG8_WAIT_L(0); PG8_BAR; PG8_MMA(0, 0, At, B0); PG8_MMA(0, 1, At, B1); PG8_BAR; PG8_SCHED;
            PG8_LDA(At, 1, 1); PG8_STAGE(PG8_SB(1, 0), b3, voffB); PG8_STAGE(PG8_SB(1, 1), b3 + hstep, voffB); PG8_STAGE(PG8_SA(1, 0), a3, voffA);
            PG8_WAIT_V(8); PG8_WAIT_L(0); PG8_BAR; PG8_MMA(1, 0, At, B0); PG8_MMA(1, 1, At, B1); PG8_BAR; PG8_SCHED;
            } else {
            PG8_LDB(B0, 0, 0); PG8_SCHED; PG8_LDA(At, 0, 0); PG8_STAGE(PG8_SA(1, 1), a1 + hstep, voffA);
            PG8_WAIT_L(8); PG8_BAR; PG8_WAIT_L(0); PG8_MMA(0, 0, At, B0); PG8_BAR; PG8_SCHED;
            PG8_LDB(B1, 0, 1); PG8_STAGE(PG8_SB(0, 0), b2, voffB);
            PG8_BAR; PG8_WAIT_L(0); PG8_MMA(0, 1, At, B1); PG8_BAR;
            PG8_LDA(At, 0, 1); PG8_STAGE(PG8_SA(0, 0), a2, voffA);
            PG8_BAR; PG8_WAIT_L(0); PG8_MMA(1, 0, At, B0); PG8_BAR; PG8_SCHED;
            PG8_STAGE(PG8_SB(0, 1), b2 + hstep, voffB);
            PG8_WAIT_V(6); PG8_BAR; PG8_MMA(1, 1, At, B1); PG8_BAR;
            PG8_LDB(B0, 1, 0); PG8_SCHED; PG8_LDA(At, 1, 0); PG8_STAGE(PG8_SA(0, 1), a2 + hstep, voffA);
            PG8_WAIT_L(8); PG8_BAR; PG8_WAIT_L(0); PG8_MMA(0, 0, At, B0); PG8_BAR; PG8_SCHED;
            PG8_LDB(B1, 1, 1); PG8_STAGE(PG8_SB(1, 0), b3, voffB);
            PG8_BAR; PG8_WAIT_L(0); PG8_MMA(0, 1, At, B1); PG8_BAR;
            PG8_LDA(At, 1, 1); PG8_STAGE(PG8_SA(1, 0), a3, voffA);
            PG8_BAR; PG8_WAIT_L(0); PG8_MMA(1, 0, At, B0); PG8_BAR; PG8_SCHED;
            PG8_STAGE(PG8_SB(1, 1), b3 + hstep, voffB);
            PG8_WAIT_V(6); PG8_BAR; PG8_MMA(1, 1, At, B1); PG8_BAR;
            }
        }
        if constexpr (ALIGN_EPI) { if (wr == 0) PG8_BAR; }
        if constexpr (!Epi::AFTER_DRAIN) { E(acc, cur, wr, wc, fr, fq); S.done(cur); }
        if (!has_next) break;
#pragma unroll
        for (int a = 0; a < 2; ++a)
#pragma unroll
            for (int b = 0; b < 2; ++b)
#pragma unroll
                for (int m = 0; m < 4; ++m)
#pragma unroll
                    for (int n = 0; n < 2; ++n) acc[a][b][m][n] = (f32x4){0.f, 0.f, 0.f, 0.f};
        cur = nxt; cA = nA; cB = nB; ++ui;
        if constexpr (ALIGN_EPI) { if (wr == 1) PG8_BAR; }
    }
    PG8_WAIT_V(0);
    if constexpr (!ALIGN_EPI) { if (wr == 0) PG8_BAR; }
    PG8_BAR;
    if constexpr (Epi::AFTER_DRAIN) { E.fused(acc, cur, wr, wc, fr, fq, lds, wid, lane); S.done(cur); }
#undef PG8_SA
#undef PG8_SB
#undef PG8_STAGE
#undef PG8_LDA
#undef PG8_LDB
#undef PG8_MMA
#undef PG8_WAIT_V
#undef PG8_WAIT_L
#undef PG8_BAR
#undef PG8_SCHED
}
}

#ifndef NSA_ZERO
#define NSA_ZERO 0
#endif

#define LAS __attribute__((address_space(3)))
typedef unsigned short bf16_t;
typedef short bf16x8 __attribute__((ext_vector_type(8)));
typedef short bf16x4 __attribute__((ext_vector_type(4)));
typedef float f32x4 __attribute__((ext_vector_type(4)));
typedef unsigned u32x4 __attribute__((ext_vector_type(4)));
typedef unsigned u32x2 __attribute__((ext_vector_type(2)));

constexpr int BATCH = 32, T = 2048, M = BATCH * T, DM = 1024, DEPTH = 2;
constexpr int NPROJ = 3584, INW = 3352, DFF = 2816;
constexpr int C_HQ = 0, C_HF = 512, C_HI = 1024, C_HG = 1536, C_NQ = 2048, C_KC = 2560, C_VC = 2688, C_KS = 2816, C_VS = 2944, C_KW = 3072, C_VW = 3200, C_GT = 3328;
constexpr float RMS_EPS = 1e-6f;
constexpr size_t MiB = 1u << 20;
constexpr size_t WS_CTL = 0, WS_WIN = 1 * MiB, WS_WOUT = 15 * MiB, WS_WFFI = 19 * MiB, WS_WFFO = 41 * MiB, WS_W1T = 52 * MiB, WS_W2T = 56 * MiB;
constexpr size_t WS_XN = 64 * MiB, WS_MIX = 192 * MiB, WS_LOGF = 320 * MiB, WS_PROJ = 448 * MiB, WS_QN = 896 * MiB;
constexpr size_t WS_KS = WS_XN, WS_KW = WS_XN + 16 * MiB, WS_VST = WS_XN + 32 * MiB, WS_VWT = WS_XN + 48 * MiB, WS_KC = WS_XN + 64 * MiB, WS_VCT = WS_XN + 65 * MiB, WS_END = 960 * MiB;
constexpr int LDS_BYTES = 143360;
constexpr int NTHREADS = 512;

struct Params { const float* in[17]; float* out; unsigned char* ws; int ph_lo, ph_hi; };

__device__ __forceinline__ float bf2f(bf16_t v) { return __uint_as_float(((unsigned)v) << 16); }
__device__ __forceinline__ unsigned pk2(float lo, float hi) { return pg8::cvt_pk_bf16(lo, hi); }
__device__ __forceinline__ bf16_t f2bf(float f) { return (bf16_t)(pk2(f, 0.f) & 0xffffu); }
__device__ __forceinline__ float wave_sum(float v) {
#pragma unroll
    for (int o = 1; o < 64; o <<= 1) v += __shfl_xor(v, o);
    return v;
}
__device__ __forceinline__ float fast_sigmoid(float x) { return __builtin_amdgcn_rcpf(1.f + __expf(-x)); }
__device__ __forceinline__ float fast_silu(float x) { return x * fast_sigmoid(x); }
#define LDS_WAIT() asm volatile("s_waitcnt lgkmcnt(0)" ::: "memory")
#define MFMA16(a, b, c) __builtin_amdgcn_mfma_f32_16x16x32_bf16((a), (b), (c), 0, 0, 0)

struct EpiProj {
    static constexpr bool PERM = true, AFTER_DRAIN = false;
    bf16_t* P; float* LOGF; const float* lb;
    __device__ __forceinline__ void operator()(const f32x4 (&acc)[2][2][4][2], const pg8::Unit& u, int wr, int wc, int fr, int fq) const {
        const int row0 = u.pm * 256 + wr * 64 + fr;
        const int col0 = u.pn * 256 + wc * 32 + 8 * fq;
        if (u.pn == 2 || u.pn == 3) {
#pragma unroll
            for (int bj = 0; bj < 2; ++bj) {
                const int cc = col0 + bj * 128 - C_HF;
                const f32x4 l0 = *(const f32x4*)(lb + cc), l1 = *(const f32x4*)(lb + cc + 4);
#pragma unroll
                for (int ai = 0; ai < 2; ++ai)
#pragma unroll
                    for (int m = 0; m < 4; ++m) {
                        const f32x4 z0 = acc[ai][bj][m][0], z1 = acc[ai][bj][m][1];
                        f32x4 o0, o1;
#pragma unroll
                        for (int e = 0; e < 4; ++e) {
                            const float s0 = 1.f / (1.f + expf(-z0[e])), s1 = 1.f / (1.f + expf(-z1[e]));
                            o0[e] = logf(l0[e] + (1.f - l0[e]) * s0); o1[e] = logf(l1[e] + (1.f - l1[e]) * s1);
                        }
                        float* dst = LOGF + (size_t)(row0 + ai * 128 + m * 16) * 512 + cc;
                        *(f32x4*)dst = o0; *(f32x4*)(dst + 4) = o1;
                    }
            }
        } else {
#pragma unroll
            for (int ai = 0; ai < 2; ++ai)
#pragma unroll
                for (int m = 0; m < 4; ++m) {
                    bf16_t* rowp = P + (size_t)(row0 + ai * 128 + m * 16) * NPROJ + col0;
#pragma unroll
                    for (int bj = 0; bj < 2; ++bj) {
                        const f32x4 v0 = acc[ai][bj][m][0], v1 = acc[ai][bj][m][1];
                        u32x4 w; w.x = pk2(v0[0], v0[1]); w.y = pk2(v0[2], v0[3]); w.z = pk2(v1[0], v1[1]); w.w = pk2(v1[2], v1[3]);
                        *(u32x4*)(rowp + bj * 128) = w;
                    }
                }
        }
    }
};
struct EpiRes {
    static constexpr bool PERM = true, AFTER_DRAIN = false;
    const float* base; float* out;
    __device__ __forceinline__ void operator()(const f32x4 (&acc)[2][2][4][2], const pg8::Unit& u, int wr, int wc, int fr, int fq) const {
        const int row0 = u.pm * 256 + wr * 64 + fr;
        const int col0 = u.pn * 256 + wc * 32 + 8 * fq;
#pragma unroll
        for (int ai = 0; ai < 2; ++ai)
#pragma unroll
            for (int m = 0; m < 4; ++m) {
                const size_t off = (size_t)(row0 + ai * 128 + m * 16) * DM + col0;
#pragma unroll
                for (int bj = 0; bj < 2; ++bj) {
                    const f32x4 b0 = *(const f32x4*)(base + off + bj * 128), b1 = *(const f32x4*)(base + off + bj * 128 + 4);
                    *(f32x4*)(out + off + bj * 128) = b0 + acc[ai][bj][m][0];
                    *(f32x4*)(out + off + bj * 128 + 4) = b1 + acc[ai][bj][m][1];
                }
            }
    }
};
struct EpiSwiGLU {
    static constexpr bool PERM = true, AFTER_DRAIN = false;
    bf16_t* A;
    __device__ __forceinline__ void operator()(const f32x4 (&acc)[2][2][4][2], const pg8::Unit& u, int wr, int wc, int fr, int fq) const {
        const int row0 = u.pm * 256 + wr * 64 + fr;
        const int col0 = u.pn * 128 + wc * 32 + 8 * fq;
#pragma unroll
        for (int ai = 0; ai < 2; ++ai)
#pragma unroll
            for (int m = 0; m < 4; ++m) {
                const f32x4 g0 = acc[ai][0][m][0], g1 = acc[ai][0][m][1], u0 = acc[ai][1][m][0], u1 = acc[ai][1][m][1];
                float r[8];
#pragma unroll
                for (int e = 0; e < 4; ++e) { r[e] = fast_silu(g0[e]) * u0[e]; r[4 + e] = fast_silu(g1[e]) * u1[e]; }
                u32x4 w; w.x = pk2(r[0], r[1]); w.y = pk2(r[2], r[3]); w.z = pk2(r[4], r[5]); w.w = pk2(r[6], r[7]);
                *(u32x4*)(A + (size_t)(row0 + ai * 128 + m * 16) * DFF + col0) = w;
            }
    }
};

__device__ __forceinline__ void transpose_item(const float* __restrict__ W, int K, int N, int nblk, bf16_t* WT, int mode, LAS float* scr, int item, int lane) {
    const int kb = item / nblk, nb = item % nblk, k0 = 64 * kb, n0 = 32 * nb;
    const int n = n0 + (lane & 31);
#pragma unroll 8
    for (int i = 0; i < 32; ++i) { const int kk = 2 * i + (lane >> 5); scr[kk * 33 + (lane & 31)] = (n < N) ? W[(size_t)(k0 + kk) * N + n] : 0.f; }
    LDS_WAIT();
    const int c = lane & 7;
#pragma unroll
    for (int j = 0; j < 4; ++j) {
        const int nl = (lane >> 3) + 8 * j, nn = n0 + nl;
        int row = nn;
        if (mode == 1) row = (nn < DFF) ? ((nn >> 7) * 256 + (nn & 127)) : ((((nn - DFF) >> 7) * 256) + 128 + ((nn - DFF) & 127));
        const LAS float* s = scr + (8 * c) * 33 + nl;
        u32x4 o; o.x = pk2(s[0 * 33], s[1 * 33]); o.y = pk2(s[2 * 33], s[3 * 33]); o.z = pk2(s[4 * 33], s[5 * 33]); o.w = pk2(s[6 * 33], s[7 * 33]);
        *(u32x4*)(WT + (size_t)row * K + k0 + 8 * c) = o;
    }
    LDS_WAIT();
}
__device__ __forceinline__ void rms_row_to_bf16(const float* xrow, const float* gain, bf16_t* orow, int lane) {
    const f32x4* xr = (const f32x4*)xrow + lane;
    const f32x4* gr = (const f32x4*)gain + lane;
    f32x4 v[4]; float s = 0.f;
#pragma unroll
    for (int j = 0; j < 4; ++j) { v[j] = xr[64 * j]; s += (v[j].x * v[j].x + v[j].y * v[j].y) + (v[j].z * v[j].z + v[j].w * v[j].w); }
    const float rstd = 1.f / sqrtf(wave_sum(s) * (1.f / DM) + RMS_EPS);
    unsigned long long* o8 = (unsigned long long*)orow + lane;
#pragma unroll
    for (int j = 0; j < 4; ++j) { const f32x4 g = gr[64 * j];
        o8[64 * j] = (unsigned long long)pk2(v[j].x * rstd * g.x, v[j].y * rstd * g.y) | ((unsigned long long)pk2(v[j].z * rstd * g.z, v[j].w * rstd * g.w) << 32); }
}
__device__ __forceinline__ void norm_phase(const float* src, const float* gain, bf16_t* XN, int gw, int NGW, int lane) {
    for (int m = gw; m < M; m += NGW) rms_row_to_bf16(src + (size_t)m * DM, gain, XN + (size_t)m * DM, lane);
}
__device__ __forceinline__ void prologue_phase(const Params& p, LAS unsigned char* lds, int gw, int NGW, int wave, int lane) {
    LAS float* scr = (LAS float*)(lds + wave * 16384);
    unsigned char* ws = p.ws;
    constexpr int I_IN = 16 * 112, I_OUT = 16 * 32, I_FFI = 16 * 176, I_FFO = 44 * 32, I_W1 = 32 * 8, I_W2 = 4 * 2;
    constexpr int PER_LAYER = I_IN + I_OUT + I_FFI + I_FFO + 2 * I_W1 + 2 * I_W2;
    for (int it = gw; it < DEPTH * PER_LAYER; it += NGW) {
        const int l = it / PER_LAYER; int r = it % PER_LAYER;
        if (r < I_IN) { transpose_item(p.in[1] + (size_t)l * DM * INW, DM, INW, 112, (bf16_t*)(ws + WS_WIN) + (size_t)l * NPROJ * DM, 0, scr, r, lane); continue; } r -= I_IN;
        if (r < I_OUT) { transpose_item(p.in[2] + (size_t)l * DM * DM, DM, DM, 32, (bf16_t*)(ws + WS_WOUT) + (size_t)l * DM * DM, 0, scr, r, lane); continue; } r -= I_OUT;
        if (r < I_FFI) { transpose_item(p.in[13] + (size_t)l * DM * 2 * DFF, DM, 2 * DFF, 176, (bf16_t*)(ws + WS_WFFI) + (size_t)l * 2 * DFF * DM, 1, scr, r, lane); continue; } r -= I_FFI;
        if (r < I_FFO) { transpose_item(p.in[14] + (size_t)l * DFF * DM, DFF, DM, 32, (bf16_t*)(ws + WS_WFFO) + (size_t)l * DM * DFF, 0, scr, r, lane); continue; } r -= I_FFO;
        if (r < I_W1) { transpose_item(p.in[8] + (size_t)l * 2048 * 256, 2048, 256, 8, (bf16_t*)(ws + WS_W1T) + (size_t)(l * 2 + 0) * 256 * 2048, 0, scr, r, lane); continue; } r -= I_W1;
        if (r < I_W1) { transpose_item(p.in[11] + (size_t)l * 2048 * 256, 2048, 256, 8, (bf16_t*)(ws + WS_W1T) + (size_t)(l * 2 + 1) * 256 * 2048, 0, scr, r, lane); continue; } r -= I_W1;
        if (r < I_W2) { transpose_item(p.in[9] + (size_t)l * 256 * 64, 256, 64, 2, (bf16_t*)(ws + WS_W2T) + (size_t)(l * 2 + 0) * 64 * 256, 0, scr, r, lane); continue; } r -= I_W2;
        transpose_item(p.in[12] + (size_t)l * 256 * 64, 256, 64, 2, (bf16_t*)(ws + WS_W2T) + (size_t)(l * 2 + 1) * 64 * 256, 0, scr, r, lane);
    }
    if (gw == 0) {
        unsigned* ctl = (unsigned*)(ws + WS_CTL);
        if (lane < 2) ctl[64 * lane] = 0u;
        float* LB = (float*)(ws + WS_CTL + 4096);
        for (int c = lane; c < 512; c += 64) { const float l0 = p.in[3][c], l1 = p.in[3][512 + c]; LB[c] = 0.f; LB[512 + c] = 1.f / (1.f + expf(l0 - l1)); }
    }
    norm_phase(p.in[0], p.in[15], (bf16_t*)(ws + WS_XN), gw, NGW, lane);
}

constexpr float ROPE_C = 0.41524101186092034f;
constexpr float QSCALE = 0.125f * 1.4426950408889634f;
__device__ __forceinline__ void prep_item(const Params& p, int l, int item, LAS unsigned char* lds, int tid, int wave, int lane) {
    const int b = item >> 5, tc = item & 31, m0 = b * T + tc * 64;
    unsigned char* ws = p.ws;
    const bf16_t* PROJ = (const bf16_t*)(ws + WS_PROJ);
    LAS bf16_t* Vt = (LAS bf16_t*)lds;
#pragma unroll
    for (int k = 0; k < 4; ++k) {
        const int c = tid + 512 * k, token = c >> 5, part = c & 31;
        const int col = part < 16 ? C_VS + part * 8 : C_VW + (part - 16) * 8;
        const u32x4 v = *(const u32x4*)(PROJ + (size_t)(m0 + token) * NPROJ + col);
        *(LAS u32x4*)(Vt + token * 264 + part * 8) = v;
    }
    {
        const int i = lane & 31, hf = lane >> 5;
        const float freq = exp2f(-(float)i * ROPE_C);
        const float* qg = p.in[5] + l * 64; const float* kg = p.in[6] + l * 192;
        const float gq1 = qg[i], gq2 = qg[i + 32], gs1 = kg[64 + i], gs2 = kg[96 + i], gw1 = kg[128 + i], gw2 = kg[160 + i];
        bf16_t* QN = (bf16_t*)(ws + WS_QN); bf16_t* KS = (bf16_t*)(ws + WS_KS); bf16_t* KW = (bf16_t*)(ws + WS_KW);
        for (int tl = 0; tl < 8; ++tl) {
            const int token = 8 * wave + tl, t = tc * 64 + token;
            float sn, cs; sincosf((float)t * freq, &sn, &cs);
            const bf16_t* row = PROJ + (size_t)(m0 + token) * NPROJ;
#pragma unroll
            for (int k = 0; k < 6; ++k) {
                const int hd = 2 * k + hf;
                const int col = hd < 8 ? C_NQ + hd * 64 : (hd < 10 ? C_KS + (hd - 8) * 64 : C_KW + (hd - 10) * 64);
                const float x1 = bf2f(row[col + i]), x2 = bf2f(row[col + 32 + i]);
                float ss = x1 * x1 + x2 * x2;
                ss += __shfl_xor(ss, 1); ss += __shfl_xor(ss, 2); ss += __shfl_xor(ss, 4); ss += __shfl_xor(ss, 8); ss += __shfl_xor(ss, 16);
                const float rstd = 1.f / sqrtf(ss * (1.f / 64.f) + RMS_EPS);
                const float g1 = hd < 8 ? gq1 : (hd < 10 ? gs1 : gw1), g2 = hd < 8 ? gq2 : (hd < 10 ? gs2 : gw2);
                const float sc = hd < 8 ? QSCALE : 1.f;
                const float y1 = x1 * rstd * g1, y2 = x2 * rstd * g2;
                const float o1 = (y1 * cs - y2 * sn) * sc, o2 = (y1 * sn + y2 * cs) * sc;
                bf16_t* dst;
                if (hd < 8) dst = QN + (((size_t)(b * 2 + (hd >> 2)) * T + t) * 4 + (hd & 3)) * 64;
                else if (hd < 10) dst = KS + ((size_t)(b * 2 + (hd - 8)) * T + t) * 64;
                else dst = KW + ((size_t)(b * 2 + (hd - 10)) * T + t) * 64;
                dst[i] = f2bf(o1); dst[i + 32] = f2bf(o2);
            }
        }
    }
    __syncthreads();
    {
        const int r = tid >> 1, h2 = tid & 1, typ = r >> 7, g = (r >> 6) & 1, d = r & 63;
        bf16_t* dst = (bf16_t*)(ws + (typ ? WS_VWT : WS_VST)) + ((size_t)(b * 2 + g) * 64 + d) * T + tc * 64 + 32 * h2;
#pragma unroll
        for (int q4 = 0; q4 < 4; ++q4) {
            unsigned w[4];
#pragma unroll
            for (int k = 0; k < 4; ++k) {
                const unsigned lo = Vt[(32 * h2 + 8 * q4 + 2 * k) * 264 + r], hi = Vt[(32 * h2 + 8 * q4 + 2 * k + 1) * 264 + r];
                w[k] = lo | (hi << 16);
            }
            *(u32x4*)(dst + 8 * q4) = (u32x4){w[0], w[1], w[2], w[3]};
        }
    }
    __syncthreads();
}

__device__ __forceinline__ void compress_item(const Params& p, int l, int ci, LAS unsigned char* lds, int tid, int wave, int lane) {
    const int half = ci & 1, kv = (ci >> 1) & 1, bg = ci >> 2, b = bg >> 1, g = bg & 1;
    const int quad = lane >> 4, r16 = lane & 15;
    unsigned char* ws = p.ws;
    const bf16_t* src = (const bf16_t*)(ws + WS_PROJ) + (size_t)b * T * NPROJ + (kv ? C_VC : C_KC) + g * 64;
    const float* pe = p.in[kv ? 10 : 7] + l * 32 * 64;
    const bf16_t* W1T = (const bf16_t*)(ws + WS_W1T) + (size_t)(l * 2 + kv) * 256 * 2048;
    const bf16_t* W2T = (const bf16_t*)(ws + WS_W2T) + (size_t)(l * 2 + kv) * 64 * 256;
    LAS bf16_t* As = (LAS bf16_t*)lds;
    LAS bf16_t* Bs = (LAS bf16_t*)(lds + 9216);
    LAS bf16_t* Hs = (LAS bf16_t*)(lds + 46080);
    LAS float* Os = (LAS float*)(lds + 79872);
    f32x4 acc[4][2];
#pragma unroll
    for (int mt = 0; mt < 4; ++mt) { acc[mt][0] = (f32x4){0.f, 0.f, 0.f, 0.f}; acc[mt][1] = (f32x4){0.f, 0.f, 0.f, 0.f}; }
    const int ar = tid >> 3, ach = tid & 7, n_a = 64 * half + ar;
    for (int ls = 0; ls < 32; ++ls) {
        int tok = 16 * n_a + ls; tok = tok > T - 1 ? T - 1 : tok;
        const u32x4 raw = *(const u32x4*)(src + (size_t)tok * NPROJ + ach * 8);
        const f32x4 pe0 = *(const f32x4*)(pe + ls * 64 + ach * 8), pe1 = *(const f32x4*)(pe + ls * 64 + ach * 8 + 4);
        u32x4 o;
        o.x = pk2(__uint_as_float(raw.x << 16) + pe0[0], __uint_as_float(raw.x & 0xffff0000u) + pe0[1]);
        o.y = pk2(__uint_as_float(raw.y << 16) + pe0[2], __uint_as_float(raw.y & 0xffff0000u) + pe0[3]);
        o.z = pk2(__uint_as_float(raw.z << 16) + pe1[0], __uint_as_float(raw.z & 0xffff0000u) + pe1[1]);
        o.w = pk2(__uint_as_float(raw.w << 16) + pe1[2], __uint_as_float(raw.w & 0xffff0000u) + pe1[3]);
        *(LAS u32x4*)(As + ar * 72 + ach * 8) = o;
#pragma unroll
        for (int k = 0; k < 4; ++k) {
            const int j = ar + 64 * k;
            const u32x4 wv = *(const u32x4*)(W1T + (size_t)j * 2048 + ls * 64 + ach * 8);
            *(LAS u32x4*)(Bs + j * 72 + ach * 8) = wv;
        }
        __syncthreads();
#pragma unroll
        for (int kb = 0; kb < 2; ++kb) {
            bf16x8 bfr[2];
#pragma unroll
            for (int nt = 0; nt < 2; ++nt) bfr[nt] = *(const LAS bf16x8*)(Bs + (32 * wave + 16 * nt + r16) * 72 + 32 * kb + 8 * quad);
#pragma unroll
            for (int mt = 0; mt < 4; ++mt) {
                const bf16x8 a = *(const LAS bf16x8*)(As + (16 * mt + r16) * 72 + 32 * kb + 8 * quad);
#pragma unroll
                for (int nt = 0; nt < 2; ++nt) acc[mt][nt] = MFMA16(a, bfr[nt], acc[mt][nt]);
            }
        }
        __syncthreads();
    }
#pragma unroll
    for (int mt = 0; mt < 4; ++mt)
#pragma unroll
        for (int nt = 0; nt < 2; ++nt)
#pragma unroll
            for (int e = 0; e < 4; ++e) { const float x = acc[mt][nt][e]; Hs[(16 * mt + 4 * quad + e) * 264 + 32 * wave + 16 * nt + r16] = f2bf(x / (1.f + expf(-x))); }
    __syncthreads();
    {
        const int mt = wave >> 1;
        f32x4 o2[2]; o2[0] = (f32x4){0.f, 0.f, 0.f, 0.f}; o2[1] = (f32x4){0.f, 0.f, 0.f, 0.f};
#pragma unroll
        for (int kb = 0; kb < 8; ++kb) {
            const bf16x8 a = *(const LAS bf16x8*)(Hs + (16 * mt + r16) * 264 + 32 * kb + 8 * quad);
#pragma unroll
            for (int dd = 0; dd < 2; ++dd) {
                const int dt = 2 * (wave & 1) + dd;
                const bf16x8 bw = *(const bf16x8*)(W2T + (size_t)(16 * dt + r16) * 256 + 32 * kb + 8 * quad);
                o2[dd] = MFMA16(a, bw, o2[dd]);
            }
        }
#pragma unroll
        for (int dd = 0; dd < 2; ++dd)
#pragma unroll
            for (int e = 0; e < 4; ++e) Os[(16 * mt + 4 * quad + e) * 65 + 16 * (2 * (wave & 1) + dd) + r16] = o2[dd][e];
    }
    __syncthreads();
    if (kv == 0) {
        const int row = tid >> 3, sub = tid & 7, n = 64 * half + row;
        float x1[4], x2[4], ss = 0.f;
#pragma unroll
        for (int k = 0; k < 4; ++k) { x1[k] = Os[row * 65 + 4 * sub + k]; x2[k] = Os[row * 65 + 32 + 4 * sub + k]; ss += x1[k] * x1[k] + x2[k] * x2[k]; }
        ss += __shfl_xor(ss, 1); ss += __shfl_xor(ss, 2); ss += __shfl_xor(ss, 4);
        const float rstd = 1.f / sqrtf(ss * (1.f / 64.f) + RMS_EPS);
        const float* kg = p.in[6] + l * 192;
        const float pos = (float)(16 * n + 31);
        bf16_t* dst = (bf16_t*)(ws + WS_KC) + ((size_t)bg * 128 + n) * 64;
#pragma unroll
        for (int k = 0; k < 4; ++k) {
            const int i = 4 * sub + k;
            float sn, cs; sincosf(pos * exp2f(-(float)i * ROPE_C), &sn, &cs);
            const float y1 = x1[k] * rstd * kg[i], y2 = x2[k] * rstd * kg[i + 32];
            float o1 = y1 * cs - y2 * sn, o2v = y1 * sn + y2 * cs;
            if (n >= 127) { o1 = 0.f; o2v = 0.f; }
            dst[i] = f2bf(o1); dst[i + 32] = f2bf(o2v);
        }
    } else {
        const int d = tid >> 3, sub = tid & 7;
        float v[8];
#pragma unroll
        for (int k = 0; k < 8; ++k) { const int r = 8 * sub + k, n = 64 * half + r; v[k] = (n >= 127) ? 0.f : Os[r * 65 + d]; }
        u32x4 o; o.x = pk2(v[0], v[1]); o.y = pk2(v[2], v[3]); o.z = pk2(v[4], v[5]); o.w = pk2(v[6], v[7]);
        *(u32x4*)((bf16_t*)(ws + WS_VCT) + ((size_t)bg * 64 + d) * 128 + 64 * half + 8 * sub) = o;
    }
    __syncthreads();
}

__device__ __forceinline__ void hgrn_item(const Params& p, int l, int item, LAS unsigned char* lds, int tid, int wave, int lane) {
    const int b = item >> 2, h = item & 3;
    const int quad = lane >> 4, r16 = lane & 15;
    unsigned char* ws = p.ws;
    const bf16_t* PROJ = (const bf16_t*)(ws + WS_PROJ);
    const float* LOGF = (const float*)(ws + WS_LOGF);
    bf16_t* MIX = (bf16_t*)(ws + WS_MIX);
    const float* gnorm = p.in[4] + l * 128;
    LAS bf16_t* Qt = (LAS bf16_t*)lds;
    LAS bf16_t* Kt = (LAS bf16_t*)(lds + 17408);
    LAS float* Ob = (LAS float*)lds;
    LAS bf16_t* Qh = (LAS bf16_t*)(lds + 34816);
    LAS bf16_t* KhT = (LAS bf16_t*)(lds + 52224);
    LAS bf16_t* VT = (LAS bf16_t*)(lds + 70656);
    LAS bf16_t* As = (LAS bf16_t*)(lds + 89088);
    LAS bf16_t* ST = (LAS bf16_t*)(lds + 98304);
    LAS float* TOT = (LAS float*)(lds + 133120);
    LAS float* DEC = (LAS float*)(lds + 135168);
    const int d = tid & 127, seg = tid >> 7;
    for (int i = tid; i < 34816 / 16; i += NTHREADS) ((LAS u32x4*)ST)[i] = (u32x4){0u, 0u, 0u, 0u};
    f32x4 S[8];
#pragma unroll
    for (int vt = 0; vt < 8; ++vt) S[vt] = (f32x4){0.f, 0.f, 0.f, 0.f};
    __syncthreads();
    for (int c = 0; c < 32; ++c) {
        const int m0 = b * T + c * 64;
        float bl[16], qs[16], lf[16];
        {
            float cum = 0.f;
#pragma unroll
            for (int r = 0; r < 16; ++r) {
                const int row = seg * 16 + r;
                const bf16_t* pr = PROJ + (size_t)(m0 + row) * NPROJ + h * 128 + d;
                lf[r] = LOGF[(size_t)(m0 + row) * 512 + h * 128 + d];
                const float q = bf2f(pr[C_HQ]);
                qs[r] = q / (1.f + __expf(-q));
                VT[d * 72 + row] = pr[C_HI];
                cum += lf[r]; bl[r] = cum;
            }
            TOT[seg * 128 + d] = cum;
        }
        __syncthreads();
        {
            const float t0 = TOT[d], t1 = TOT[128 + d], t2 = TOT[256 + d], t3 = TOT[384 + d];
            const float off = seg == 0 ? 0.f : (seg == 1 ? t0 : (seg == 2 ? t0 + t1 : t0 + t1 + t2));
            const float bmid = t0 + t1, blast = (t0 + t1) + (t2 + t3);
            if (seg == 0) DEC[d] = __expf(blast);
#pragma unroll
            for (int r = 0; r < 16; ++r) {
                const int row = seg * 16 + r;
                const float bb = off + bl[r];
                const float k = -expm1f(lf[r]);
                Qt[row * 136 + d] = f2bf(qs[r] * __expf(bb - bmid));
                Kt[row * 136 + d] = f2bf(k * __expf(bmid - bb));
                Qh[row * 136 + d] = f2bf(qs[r] * __expf(bb));
                KhT[d * 72 + row] = f2bf(k * __expf(blast - bb));
            }
        }
        __syncthreads();
        {
            const int tt = wave >> 1, st0 = 2 * (wave & 1);
            f32x4 a2[2]; a2[0] = (f32x4){0.f, 0.f, 0.f, 0.f}; a2[1] = (f32x4){0.f, 0.f, 0.f, 0.f};
#pragma unroll
            for (int kb = 0; kb < 4; ++kb) {
                const bf16x8 a = *(const LAS bf16x8*)(Qt + (16 * tt + r16) * 136 + 32 * kb + 8 * quad);
#pragma unroll
                for (int j = 0; j < 2; ++j) { const bf16x8 bq = *(const LAS bf16x8*)(Kt + (16 * (st0 + j) + r16) * 136 + 32 * kb + 8 * quad); a2[j] = MFMA16(a, bq, a2[j]); }
            }
#pragma unroll
            for (int j = 0; j < 2; ++j)
#pragma unroll
                for (int e = 0; e < 4; ++e) { const int t = 16 * tt + 4 * quad + e, s = 16 * (st0 + j) + r16; As[t * 72 + s] = f2bf(s <= t ? a2[j][e] : 0.f); }
        }
        __syncthreads();
        {
            const int tt = wave & 3, vt0 = 4 * (wave >> 2);
            f32x4 o4[4];
#pragma unroll
            for (int j = 0; j < 4; ++j) o4[j] = (f32x4){0.f, 0.f, 0.f, 0.f};
#pragma unroll
            for (int kb = 0; kb < 2; ++kb) {
                const bf16x8 a = *(const LAS bf16x8*)(As + (16 * tt + r16) * 72 + 32 * kb + 8 * quad);
#pragma unroll
                for (int j = 0; j < 4; ++j) { const bf16x8 bv = *(const LAS bf16x8*)(VT + (16 * (vt0 + j) + r16) * 72 + 32 * kb + 8 * quad); o4[j] = MFMA16(a, bv, o4[j]); }
            }
#pragma unroll
            for (int kb = 0; kb < 4; ++kb) {
                const bf16x8 a = *(const LAS bf16x8*)(Qh + (16 * tt + r16) * 136 + 32 * kb + 8 * quad);
#pragma unroll
                for (int j = 0; j < 4; ++j) { const bf16x8 bs = *(const LAS bf16x8*)(ST + (16 * (vt0 + j) + r16) * 136 + 32 * kb + 8 * quad); o4[j] = MFMA16(a, bs, o4[j]); }
            }
#pragma unroll
            for (int j = 0; j < 4; ++j)
#pragma unroll
                for (int e = 0; e < 4; ++e) Ob[(16 * tt + 4 * quad + e) * 132 + 16 * (vt0 + j) + r16] = o4[j][e];
        }
        {
            const f32x4 dec = *(const LAS f32x4*)(DEC + 16 * wave + 4 * quad);
#pragma unroll
            for (int vt = 0; vt < 8; ++vt) S[vt] = S[vt] * dec;
#pragma unroll
            for (int kb = 0; kb < 2; ++kb) {
                const bf16x8 a = *(const LAS bf16x8*)(KhT + (16 * wave + r16) * 72 + 32 * kb + 8 * quad);
#pragma unroll
                for (int vt = 0; vt < 8; ++vt) { const bf16x8 bv = *(const LAS bf16x8*)(VT + (16 * vt + r16) * 72 + 32 * kb + 8 * quad); S[vt] = MFMA16(a, bv, S[vt]); }
            }
        }
        __syncthreads();
#pragma unroll
        for (int vt = 0; vt < 8; ++vt) { u32x2 w; w.x = pk2(S[vt][0], S[vt][1]); w.y = pk2(S[vt][2], S[vt][3]); *(LAS u32x2*)(ST + (16 * vt + r16) * 136 + 16 * wave + 4 * quad) = w; }
        {
            const int row = tid >> 3, sub = tid & 7;
            float ov[16], ss = 0.f;
#pragma unroll
            for (int k = 0; k < 16; ++k) { ov[k] = Ob[row * 132 + 16 * sub + k]; ss += ov[k] * ov[k]; }
            ss += __shfl_xor(ss, 1); ss += __shfl_xor(ss, 2); ss += __shfl_xor(ss, 4);
            const float rstd = 1.f / sqrtf(ss * (1.f / 128.f) + RMS_EPS);
            const bf16_t* gp = PROJ + (size_t)(m0 + row) * NPROJ + C_HG + h * 128 + 16 * sub;
            const u32x4 g0 = *(const u32x4*)gp, g1 = *(const u32x4*)(gp + 8);
            const unsigned gw[8] = {g0.x, g0.y, g0.z, g0.w, g1.x, g1.y, g1.z, g1.w};
            unsigned w[8];
#pragma unroll
            for (int k = 0; k < 8; ++k) {
                const float ga = __uint_as_float(gw[k] << 16), gb = __uint_as_float(gw[k] & 0xffff0000u);
                const float ra = ov[2 * k] * rstd * gnorm[16 * sub + 2 * k] * (ga / (1.f + __expf(-ga)));
                const float rb = ov[2 * k + 1] * rstd * gnorm[16 * sub + 2 * k + 1] * (gb / (1.f + __expf(-gb)));
                w[k] = pk2(ra, rb);
            }
            bf16_t* dst = MIX + (size_t)(m0 + row) * DM + h * 128 + 16 * sub;
            *(u32x4*)dst = (u32x4){w[0], w[1], w[2], w[3]}; *(u32x4*)(dst + 8) = (u32x4){w[4], w[5], w[6], w[7]};
        }
        __syncthreads();
    }
}

__device__ __forceinline__ void hgrn_item_naive(const Params& p, int l, int item, LAS unsigned char* lds, int tid, int wave, int lane) {
    const int b = item >> 2, h = item & 3;
    unsigned char* ws = p.ws;
    const bf16_t* PROJ = (const bf16_t*)(ws + WS_PROJ);
    const float* LOGF = (const float*)(ws + WS_LOGF);
    bf16_t* MIX = (bf16_t*)(ws + WS_MIX);
    const float* gnorm = p.in[4] + l * 128;
    LAS float* Ob = (LAS float*)lds;
    LAS float* Fq = (LAS float*)(lds + 33792);
    LAS float* Ff = (LAS float*)(lds + 66560);
    LAS float* Pp = (LAS float*)(lds + 99328);
    const int v = tid & 127, dg = tid >> 7;
    float S[32];
#pragma unroll
    for (int i = 0; i < 32; ++i) S[i] = 0.f;
    for (int c = 0; c < 32; ++c) {
        const int m0 = b * T + c * 64;
        float vv[16];
        {
            const int d = tid & 127, seg = tid >> 7;
#pragma unroll
            for (int r = 0; r < 16; ++r) {
                const int row = seg * 16 + r;
                const bf16_t* pr = PROJ + (size_t)(m0 + row) * NPROJ + h * 128 + d;
                const float lf = LOGF[(size_t)(m0 + row) * 512 + h * 128 + d];
                const float q = bf2f(pr[C_HQ]);
                Fq[row * 128 + d] = q / (1.f + expf(-q));
                Ff[row * 128 + d] = expf(lf);
            }
        }
        __syncthreads();
        for (int t = 0; t < 64; ++t) {
            const float vt = bf2f(PROJ[(size_t)(m0 + t) * NPROJ + C_HI + h * 128 + v]);
            float part = 0.f;
#pragma unroll
            for (int i4 = 0; i4 < 8; ++i4) {
                const f32x4 f4 = *(const LAS f32x4*)(Ff + t * 128 + dg * 32 + 4 * i4);
                const f32x4 q4 = *(const LAS f32x4*)(Fq + t * 128 + dg * 32 + 4 * i4);
#pragma unroll
                for (int e = 0; e < 4; ++e) { const int i = 4 * i4 + e; S[i] = f4[e] * S[i] + (1.f - f4[e]) * vt; part += q4[e] * S[i]; }
            }
            Pp[(t & 1) * 512 + dg * 128 + v] = part;
            __syncthreads();
            if (dg == 0) Ob[t * 132 + v] = (Pp[(t & 1) * 512 + v] + Pp[(t & 1) * 512 + 128 + v]) + (Pp[(t & 1) * 512 + 256 + v] + Pp[(t & 1) * 512 + 384 + v]);
        }
        __syncthreads();
        {
            const int row = tid >> 3, sub = tid & 7;
            float ov[16], ss = 0.f;
#pragma unroll
            for (int k = 0; k < 16; ++k) { ov[k] = Ob[row * 132 + 16 * sub + k]; ss += ov[k] * ov[k]; }
            ss += __shfl_xor(ss, 1); ss += __shfl_xor(ss, 2); ss += __shfl_xor(ss, 4);
            const float rstd = 1.f / sqrtf(ss * (1.f / 128.f) + RMS_EPS);
            const bf16_t* gp = PROJ + (size_t)(m0 + row) * NPROJ + C_HG + h * 128 + 16 * sub;
            bf16_t* dst = MIX + (size_t)(m0 + row) * DM + h * 128 + 16 * sub;
#pragma unroll
            for (int k = 0; k < 16; ++k) { const float ga = bf2f(gp[k]); dst[k] = f2bf(ov[k] * rstd * gnorm[16 * sub + k] * (ga / (1.f + expf(-ga)))); }
        }
        __syncthreads();
    }
}

template <bool DUAL, class F>
__device__ __forceinline__ void naive_gemm(const bf16_t* A, int K, const float* W, int ldw, int ncols, int dual_off, LAS unsigned char* lds, int bid, int G, int tid, const F& store) {
    LAS float* As = (LAS float*)lds;
    LAS float* Bs = (LAS float*)(lds + 8448);
    LAS float* Bs2 = (LAS float*)(lds + 8448 + 16384);
    const int nct = (ncols + 127) / 128, ntiles = (M / 64) * nct;
    const int tr = tid >> 5, tc = tid & 31;
    for (int tile = bid; tile < ntiles; tile += G) {
        const int rt = tile / nct, ct = tile % nct, r0 = rt * 64, c0 = ct * 128;
        float acc[4][4], acc2[4][4];
#pragma unroll
        for (int i = 0; i < 4; ++i)
#pragma unroll
            for (int j = 0; j < 4; ++j) { acc[i][j] = 0.f; acc2[i][j] = 0.f; }
        for (int k0 = 0; k0 < K; k0 += 32) {
            __syncthreads();
#pragma unroll
            for (int q = 0; q < 4; ++q) { const int e = tid + 512 * q, r = e >> 5, kk = e & 31; As[r * 33 + kk] = bf2f(A[(size_t)(r0 + r) * K + k0 + kk]); }
#pragma unroll
            for (int q = 0; q < 8; ++q) { const int e = tid + 512 * q, kk = e >> 7, c = e & 127; const int col = c0 + c;
                Bs[kk * 128 + c] = (col < ncols) ? W[(size_t)(k0 + kk) * ldw + col] : 0.f;
                if (DUAL) Bs2[kk * 128 + c] = (col < ncols) ? W[(size_t)(k0 + kk) * ldw + dual_off + col] : 0.f; }
            __syncthreads();
            for (int kk = 0; kk < 32; ++kk) {
                float a[4], b[4], b2[4];
#pragma unroll
                for (int i = 0; i < 4; ++i) a[i] = As[(4 * tr + i) * 33 + kk];
#pragma unroll
                for (int j = 0; j < 4; ++j) { b[j] = Bs[kk * 128 + tc + 32 * j]; b2[j] = DUAL ? Bs2[kk * 128 + tc + 32 * j] : 0.f; }
#pragma unroll
                for (int i = 0; i < 4; ++i)
#pragma unroll
                    for (int j = 0; j < 4; ++j) { acc[i][j] += a[i] * b[j]; if (DUAL) acc2[i][j] += a[i] * b2[j]; }
            }
        }
#pragma unroll
        for (int i = 0; i < 4; ++i)
#pragma unroll
            for (int j = 0; j < 4; ++j) { const int col = c0 + tc + 32 * j; if (col < ncols) store(r0 + 4 * tr + i, col, acc[i][j], acc2[i][j]); }
    }
    __syncthreads();
}
struct StProj { bf16_t* P; float* LOGF; const float* lb;
    __device__ __forceinline__ void operator()(int row, int col, float v, float) const {
        if (col >= C_HF && col < C_HI) { const float l = lb[col - C_HF]; const float s = 1.f / (1.f + expf(-v)); LOGF[(size_t)row * 512 + col - C_HF] = logf(l + (1.f - l) * s); }
        else P[(size_t)row * NPROJ + col] = f2bf(v); } };
struct StRes { const float* base; float* out;
    __device__ __forceinline__ void operator()(int row, int col, float v, float) const { out[(size_t)row * DM + col] = base[(size_t)row * DM + col] + v; } };
struct StSwi { bf16_t* A;
    __device__ __forceinline__ void operator()(int row, int col, float g, float u) const { A[(size_t)row * DFF + col] = f2bf(g / (1.f + expf(-g)) * u); } };

template <int MODE>
__device__ __forceinline__ void attn_tile(const LAS bf16_t* Ks, const LAS bf16_t* Vs, const bf16x8 (&qf)[2][2], f32x4 (&o)[2][4], float (&mrow)[2], float (&lrow)[2],
                                          const int (&tk)[2], const unsigned (&selm)[2], int j, int quad, int r16) {
#pragma unroll
    for (int rt = 0; rt < 2; ++rt) {
        f32x4 s[4];
#pragma unroll
        for (int kt = 0; kt < 4; ++kt) {
            s[kt] = (f32x4){0.f, 0.f, 0.f, 0.f};
#pragma unroll
            for (int kb = 0; kb < 2; ++kb) {
                const bf16x8 a = *(const LAS bf16x8*)(Ks + (16 * kt + r16) * 72 + 32 * kb + 8 * quad);
                s[kt] = MFMA16(a, qf[rt][kb], s[kt]);
            }
        }
        const bool blk = (MODE == 1) ? (((selm[rt] >> j) & 1u) != 0u) : true;
        const int kbase = 64 * j + 4 * quad;
        const int hi = blk ? tk[rt] : -1;
        const int lo = (MODE == 2) ? tk[rt] - 512 : -1;
        float mx = -1e30f;
#pragma unroll
        for (int kt = 0; kt < 4; ++kt)
#pragma unroll
            for (int e = 0; e < 4; ++e) {
                const int kpos = kbase + 16 * kt + e;
                const bool v = (kpos <= hi) && (kpos > lo);
                s[kt][e] = v ? s[kt][e] : -1e30f;
                mx = fmaxf(mx, s[kt][e]);
            }
        mx = fmaxf(mx, __shfl_xor(mx, 16)); mx = fmaxf(mx, __shfl_xor(mx, 32));
        const float mnew = fmaxf(mrow[rt], mx);
        const float alpha = __builtin_amdgcn_exp2f(mrow[rt] - mnew);
        mrow[rt] = mnew;
        float rs = 0.f;
#pragma unroll
        for (int kt = 0; kt < 4; ++kt)
#pragma unroll
            for (int e = 0; e < 4; ++e) { const float pv = (s[kt][e] > -1e29f) ? __builtin_amdgcn_exp2f(s[kt][e] - mnew) : 0.f; s[kt][e] = pv; rs += pv; }
        rs += __shfl_xor(rs, 16); rs += __shfl_xor(rs, 32);
        lrow[rt] = lrow[rt] * alpha + rs;
#pragma unroll
        for (int dt = 0; dt < 4; ++dt) o[rt][dt] = o[rt][dt] * alpha;
        bf16x8 pf[2];
#pragma unroll
        for (int kb2 = 0; kb2 < 2; ++kb2) {
            u32x4 w;
            w.x = pk2(s[2 * kb2][0], s[2 * kb2][1]); w.y = pk2(s[2 * kb2][2], s[2 * kb2][3]);
            w.z = pk2(s[2 * kb2 + 1][0], s[2 * kb2 + 1][1]); w.w = pk2(s[2 * kb2 + 1][2], s[2 * kb2 + 1][3]);
            pf[kb2] = __builtin_bit_cast(bf16x8, w);
        }
#pragma unroll
        for (int dt = 0; dt < 4; ++dt)
#pragma unroll
            for (int kb2 = 0; kb2 < 2; ++kb2) {
                const u32x2 v0 = *(const LAS u32x2*)(Vs + (16 * dt + r16) * 136 + 32 * kb2 + 4 * quad);
                const u32x2 v1 = *(const LAS u32x2*)(Vs + (16 * dt + r16) * 136 + 32 * kb2 + 16 + 4 * quad);
                const bf16x8 vf = __builtin_bit_cast(bf16x8, ((u32x4){v0.x, v0.y, v1.x, v1.y}));
                o[rt][dt] = MFMA16(vf, pf[kb2], o[rt][dt]);
            }
    }
}

template <int MODE>
__device__ __forceinline__ void attn_branch(const bf16_t* Kb, const bf16_t* VTb, LAS bf16_t* Ks, LAS bf16_t* Vs, const bf16x8 (&qf)[2][2], f32x4 (&out)[2][4],
                                            const float (&gsc)[2], const int (&tk)[2], const unsigned (&selm)[2], unsigned uni, int jlo, int jhi, int tid, int quad, int r16) {
    f32x4 o[2][4];
#pragma unroll
    for (int rt = 0; rt < 2; ++rt)
#pragma unroll
        for (int dt = 0; dt < 4; ++dt) o[rt][dt] = (f32x4){0.f, 0.f, 0.f, 0.f};
    float mrow[2] = {-1e30f, -1e30f}, lrow[2] = {0.f, 0.f};
    const int lr = tid >> 3, lc = (tid & 7) * 8;
    int j = jlo; while (j <= jhi && !((uni >> j) & 1u)) ++j;
    u32x4 kreg = (u32x4){0u, 0u, 0u, 0u}, vreg = (u32x4){0u, 0u, 0u, 0u};
    if (j <= jhi) { kreg = *(const u32x4*)(Kb + (size_t)(64 * j + lr) * 64 + lc); vreg = *(const u32x4*)(VTb + (size_t)lr * T + 64 * j + lc); }
    while (j <= jhi) {
        __syncthreads();
        *(LAS u32x4*)(Ks + lr * 72 + lc) = kreg; *(LAS u32x4*)(Vs + lr * 136 + lc) = vreg;
        int jn = j + 1; while (jn <= jhi && !((uni >> jn) & 1u)) ++jn;
        if (jn <= jhi) { kreg = *(const u32x4*)(Kb + (size_t)(64 * jn + lr) * 64 + lc); vreg = *(const u32x4*)(VTb + (size_t)lr * T + 64 * jn + lc); }
        __syncthreads();
        attn_tile<MODE>(Ks, Vs, qf, o, mrow, lrow, tk, selm, j, quad, r16);
        j = jn;
    }
#pragma unroll
    for (int rt = 0; rt < 2; ++rt) {
        const float inv = lrow[rt] > 0.f ? gsc[rt] / lrow[rt] : 0.f;
#pragma unroll
        for (int dt = 0; dt < 4; ++dt) out[rt][dt] = out[rt][dt] + o[rt][dt] * inv;
    }
}

__device__ __forceinline__ void nsa_unit(const Params& p, int l, int item, LAS unsigned char* lds, int tid, int wave, int lane) {
    const int qt = 31 - (item >> 6), bg = item & 63, b = bg >> 1, g = bg & 1, t0 = qt * 64;
    const int quad = lane >> 4, r16 = lane & 15, hh = lane & 3;
    unsigned char* ws = p.ws;
    const bf16_t* PROJ = (const bf16_t*)(ws + WS_PROJ);
    LAS bf16_t* Ks = (LAS bf16_t*)lds;
    LAS bf16_t* Vs = (LAS bf16_t*)(lds + 18432);
    LAS float* IMP = (LAS float*)(lds + 35840);
    LAS unsigned* SEL = (LAS unsigned*)(lds + 44288);
    int tk[2]; tk[0] = t0 + 8 * wave + (r16 >> 2); tk[1] = tk[0] + 4;
    bf16x8 qf[2][2];
    {
        const bf16_t* Qb = (const bf16_t*)(ws + WS_QN) + ((size_t)bg * T + t0) * 256;
#pragma unroll
        for (int rt = 0; rt < 2; ++rt)
#pragma unroll
            for (int kb = 0; kb < 2; ++kb) qf[rt][kb] = *(const bf16x8*)(Qb + (size_t)(32 * wave + 16 * rt + r16) * 64 + 32 * kb + 8 * quad);
    }
    float gt[3][2];
#pragma unroll
    for (int rt = 0; rt < 2; ++rt)
#pragma unroll
        for (int br = 0; br < 3; ++br) { const float z = bf2f(PROJ[(size_t)(b * T + tk[rt]) * NPROJ + C_GT + (g * 4 + hh) * 3 + br]); gt[br][rt] = 1.f / (1.f + __expf(-z)); }
    f32x4 out[2][4];
#pragma unroll
    for (int rt = 0; rt < 2; ++rt)
#pragma unroll
        for (int dt = 0; dt < 4; ++dt) out[rt][dt] = (f32x4){0.f, 0.f, 0.f, 0.f};
    {
        const bf16_t* KCb = (const bf16_t*)(ws + WS_KC) + (size_t)bg * 128 * 64;
        const bf16_t* VCb = (const bf16_t*)(ws + WS_VCT) + (size_t)bg * 64 * 128;
#pragma unroll
        for (int k = 0; k < 2; ++k) {
            const int c = tid + 512 * k;
            *(LAS u32x4*)(Ks + (c >> 3) * 72 + (c & 7) * 8) = *(const u32x4*)(KCb + (size_t)(c >> 3) * 64 + (c & 7) * 8);
            *(LAS u32x4*)(Vs + (c >> 4) * 136 + (c & 15) * 8) = *(const u32x4*)(VCb + (size_t)(c >> 4) * 128 + (c & 15) * 8);
        }
        __syncthreads();
#pragma unroll
        for (int rt = 0; rt < 2; ++rt) {
            f32x4 s[8];
#pragma unroll
            for (int kt = 0; kt < 8; ++kt) {
                s[kt] = (f32x4){0.f, 0.f, 0.f, 0.f};
#pragma unroll
                for (int kb = 0; kb < 2; ++kb) { const bf16x8 a = *(const LAS bf16x8*)(Ks + (16 * kt + r16) * 72 + 32 * kb + 8 * quad); s[kt] = MFMA16(a, qf[rt][kb], s[kt]); }
            }
            float mx = -1e30f;
#pragma unroll
            for (int kt = 0; kt < 8; ++kt)
#pragma unroll
                for (int e = 0; e < 4; ++e) { const int n = 16 * kt + 4 * quad + e; const bool v = (16 * n + 31 <= tk[rt]); mx = fmaxf(mx, v ? s[kt][e] : -1e30f); }
            mx = fmaxf(mx, __shfl_xor(mx, 16)); mx = fmaxf(mx, __shfl_xor(mx, 32));
            float rs = 0.f;
#pragma unroll
            for (int kt = 0; kt < 8; ++kt)
#pragma unroll
                for (int e = 0; e < 4; ++e) { const int n = 16 * kt + 4 * quad + e; const bool v = (16 * n + 31 <= tk[rt]); const float pv = v ? exp2f(s[kt][e] - mx) : 0.f; s[kt][e] = pv; rs += pv; }
            rs += __shfl_xor(rs, 16); rs += __shfl_xor(rs, 32);
            const float inv = rs > 0.f ? 1.f / rs : 0.f;
#pragma unroll
            for (int kt = 0; kt < 8; ++kt) s[kt] = s[kt] * inv;
            if (qt >= 16) {
                float sh[8];
#pragma unroll
                for (int kt = 0; kt < 8; ++kt) sh[kt] = __shfl(s[kt][3], (lane + 48) & 63);
#pragma unroll
                for (int kt = 0; kt < 8; ++kt) {
                    const float nb = quad ? sh[kt] : (kt ? sh[kt > 0 ? kt - 1 : 0] : 0.f);
                    float im = (s[kt][0] + s[kt][1]) + (s[kt][2] + s[kt][3]) + nb;
                    im += __shfl_xor(im, 1); im += __shfl_xor(im, 2);
                    if (hh == 0) IMP[(8 * wave + 4 * rt + (r16 >> 2)) * 33 + 4 * kt + quad] = im;
                }
            }
            const float gs = gt[0][rt];
#pragma unroll
            for (int dt = 0; dt < 4; ++dt) {
                f32x4 oc = (f32x4){0.f, 0.f, 0.f, 0.f};
#pragma unroll
                for (int kb2 = 0; kb2 < 4; ++kb2) {
                    u32x4 w;
                    w.x = pk2(s[2 * kb2][0], s[2 * kb2][1]); w.y = pk2(s[2 * kb2][2], s[2 * kb2][3]);
                    w.z = pk2(s[2 * kb2 + 1][0], s[2 * kb2 + 1][1]); w.w = pk2(s[2 * kb2 + 1][2], s[2 * kb2 + 1][3]);
                    const bf16x8 pfr = __builtin_bit_cast(bf16x8, w);
                    const u32x2 v0 = *(const LAS u32x2*)(Vs + (16 * dt + r16) * 136 + 32 * kb2 + 4 * quad);
                    const u32x2 v1 = *(const LAS u32x2*)(Vs + (16 * dt + r16) * 136 + 32 * kb2 + 16 + 4 * quad);
                    const bf16x8 vf = __builtin_bit_cast(bf16x8, ((u32x4){v0.x, v0.y, v1.x, v1.y}));
                    oc = MFMA16(vf, pfr, oc);
                }
                out[rt][dt] = out[rt][dt] + oc * gs;
            }
            asm volatile("" ::: "memory");
        }
    }
    unsigned selm[2], uni;
    if (qt >= 16) {
        __syncthreads();
#pragma unroll
        for (int ps = 0; ps < 4; ++ps) {
            const int token = 16 * ps + (tid >> 5), j = tid & 31;
            const float my = IMP[token * 33 + j];
            int rank = 0;
            for (int jj = 1; jj <= qt - 2; ++jj) { const float ov = IMP[token * 33 + jj]; rank += ((ov > my) || (ov == my && jj < j)) ? 1 : 0; }
            const bool sel = (j == 0) || (j == qt) || (j == qt - 1) || (j >= 1 && j <= qt - 2 && rank < 13);
            const unsigned long long bal = __ballot(sel);
            if ((lane & 31) == 0) SEL[token] = (lane < 32) ? (unsigned)bal : (unsigned)(bal >> 32);
        }
        __syncthreads();
        selm[0] = SEL[8 * wave + (r16 >> 2)]; selm[1] = SEL[8 * wave + 4 + (r16 >> 2)];
        uni = 0u;
        for (int k = 0; k < 64; ++k) uni |= SEL[k];
        uni = __builtin_amdgcn_readfirstlane(uni);
    } else { selm[0] = selm[1] = uni = (2u << qt) - 1u; }
    {
        const float gsc[2] = {gt[1][0], gt[1][1]};
        attn_branch<1>((const bf16_t*)(ws + WS_KS) + (size_t)bg * T * 64, (const bf16_t*)(ws + WS_VST) + (size_t)bg * 64 * T, Ks, Vs, qf, out, gsc, tk, selm, uni, 0, qt, tid, quad, r16);
    }
    {
        const float gsc[2] = {gt[2][0], gt[2][1]};
        attn_branch<2>((const bf16_t*)(ws + WS_KW) + (size_t)bg * T * 64, (const bf16_t*)(ws + WS_VWT) + (size_t)bg * 64 * T, Ks, Vs, qf, out, gsc, tk, selm, 0xffffffffu, qt > 8 ? qt - 8 : 0, qt, tid, quad, r16);
    }
    {
        bf16_t* MIX = (bf16_t*)(ws + WS_MIX);
#pragma unroll
        for (int rt = 0; rt < 2; ++rt)
#pragma unroll
            for (int dt = 0; dt < 4; ++dt) {
                u32x2 w; w.x = pk2(out[rt][dt][0], out[rt][dt][1]); w.y = pk2(out[rt][dt][2], out[rt][dt][3]);
                if (NSA_ZERO) { w.x = 0u; w.y = 0u; }
                *(u32x2*)(MIX + (size_t)(b * T + tk[rt]) * DM + 512 + (g * 4 + hh) * 64 + 16 * dt + 4 * quad) = w;
            }
    }
    __syncthreads();
}

#ifndef NAIVE_MASK
#define NAIVE_MASK 0
#endif
#ifndef HG_NAIVE
#define HG_NAIVE 0
#endif
#ifndef PHMASK
#define PHMASK 0x1ff
#endif
constexpr int N_PHASES = 1 + 8 * DEPTH;
__global__ void __launch_bounds__(NTHREADS) fwd_kernel(Params p) {
    extern __shared__ __attribute__((aligned(16))) unsigned char lds_raw[];
    LAS unsigned char* lds = (LAS unsigned char*)lds_raw;
    const int G = gridDim.x, NGW = G * 8;
    unsigned char* ws = p.ws;
    for (int ph = p.ph_lo; ph < p.ph_hi; ++ph) {
        if (ph > p.ph_lo) {
            asm volatile("s_waitcnt vmcnt(0)" ::: "memory");
            __syncthreads();
            cg::this_grid().sync();
            __builtin_amdgcn_fence(__ATOMIC_ACQUIRE, "agent");
            asm volatile("s_waitcnt vmcnt(0)" ::: "memory");
            __syncthreads();
        }
        int tid = threadIdx.x; asm volatile("" : "+v"(tid));
        int bid = blockIdx.x; asm volatile("" : "+s"(bid));
        const int lane = tid & 63, wave = __builtin_amdgcn_readfirstlane(tid >> 6), gw = bid * 8 + wave;
        if (ph == 0) { if (PHMASK & 1) prologue_phase(p, lds, gw, NGW, wave, lane); continue; }
        const int l = (ph - 1) >> 3, sub = (ph - 1) & 7;
        if (sub == 0 && (PHMASK & 2)) {
            pg8::Gemm g{(const bf16_t*)(ws + WS_XN), (const bf16_t*)(ws + WS_WIN) + (size_t)l * NPROJ * DM, M, NPROJ, DM};
            pg8::StaticOrder S; S.init(M, NPROJ, G, bid);
            EpiProj E{(bf16_t*)(ws + WS_PROJ), (float*)(ws + WS_LOGF), (const float*)(ws + WS_CTL + 4096) + l * 512};
            if (NAIVE_MASK & 1) { StProj st{(bf16_t*)(ws + WS_PROJ), (float*)(ws + WS_LOGF), (const float*)(ws + WS_CTL + 4096) + l * 512};
                naive_gemm<false>((const bf16_t*)(ws + WS_XN), DM, p.in[1] + (size_t)l * DM * INW, INW, INW, 0, lds, bid, G, tid, st); }
            else pg8::gemm_phase<EpiProj, pg8::StaticOrder, true, true>(lds, g, S, E, tid);
        } else if (sub == 1 && (PHMASK & 4)) {
            for (int it = bid; it < 256 + 1024; it += G) {
                int t2 = tid; asm volatile("" : "+v"(t2));
                const int l2 = t2 & 63, w2 = __builtin_amdgcn_readfirstlane(t2 >> 6);
                if (it < 256) compress_item(p, l, it, lds, t2, w2, l2);
                else prep_item(p, l, it - 256, lds, t2, w2, l2);
            }
        } else if (sub == 2 && (PHMASK & 8)) {
            unsigned* ctr = (unsigned*)(ws + WS_CTL) + 64 * l;
            LAS int* qslot = (LAS int*)(lds + LDS_BYTES - 16);
            for (;;) {
                if (tid == 0) *qslot = (int)atomicAdd(ctr, 1u);
                __syncthreads();
                const int item = *qslot;
                __syncthreads();
                if (item >= 128 + 2048) break;
                int t2 = tid; asm volatile("" : "+v"(t2));
                const int l2 = t2 & 63, w2 = __builtin_amdgcn_readfirstlane(t2 >> 6);
                if (item < 128) { if (HG_NAIVE) hgrn_item_naive(p, l, item, lds, t2, w2, l2); else hgrn_item(p, l, item, lds, t2, w2, l2); }
                else { if (PHMASK & 256) nsa_unit(p, l, item - 128, lds, t2, w2, l2); }
            }
        } else if ((sub == 3 || sub == 6) && (PHMASK & 16)) {
            const bool ffn = (sub == 6);
            pg8::Gemm g{ffn ? (const bf16_t*)(ws + WS_PROJ) : (const bf16_t*)(ws + WS_MIX),
                        ffn ? (const bf16_t*)(ws + WS_WFFO) + (size_t)l * DM * DFF : (const bf16_t*)(ws + WS_WOUT) + (size_t)l * DM * DM, M, DM, ffn ? DFF : DM};
            pg8::StaticOrder S; S.init(M, DM, G, bid);
            EpiRes E{(l == 0 && !ffn) ? p.in[0] : (const float*)p.out, p.out};
            if (!ffn && (NAIVE_MASK & 2)) { StRes st{(l == 0) ? p.in[0] : (const float*)p.out, p.out};
                naive_gemm<false>((const bf16_t*)(ws + WS_MIX), DM, p.in[2] + (size_t)l * DM * DM, DM, DM, 0, lds, bid, G, tid, st); }
            else if (ffn && (NAIVE_MASK & 8)) { StRes st{(const float*)p.out, p.out};
                naive_gemm<false>((const bf16_t*)(ws + WS_PROJ), DFF, p.in[14] + (size_t)l * DFF * DM, DM, DM, 0, lds, bid, G, tid, st); }
            else pg8::gemm_phase<EpiRes, pg8::StaticOrder, true, true>(lds, g, S, E, tid);
        } else if (sub == 4 && (PHMASK & 32)) {
            norm_phase(p.out, p.in[16] + l * DM, (bf16_t*)(ws + WS_XN), gw, NGW, lane);
        } else if (sub == 5 && (PHMASK & 64)) {
            pg8::Gemm g{(const bf16_t*)(ws + WS_XN), (const bf16_t*)(ws + WS_WFFI) + (size_t)l * 2 * DFF * DM, M, 2 * DFF, DM};
            pg8::StaticOrder S; S.init(M, 2 * DFF, G, bid);
            EpiSwiGLU E{(bf16_t*)(ws + WS_PROJ)};
            if (NAIVE_MASK & 4) { StSwi st{(bf16_t*)(ws + WS_PROJ)};
                naive_gemm<true>((const bf16_t*)(ws + WS_XN), DM, p.in[13] + (size_t)l * DM * 2 * DFF, 2 * DFF, DFF, DFF, lds, bid, G, tid, st); }
            else pg8::gemm_phase<EpiSwiGLU, pg8::StaticOrder, true, true>(lds, g, S, E, tid);
        } else if (sub == 7) {
            if (l + 1 < DEPTH) norm_phase(p.out, p.in[15] + (l + 1) * DM, (bf16_t*)(ws + WS_XN), gw, NGW, lane);
        }
    }
}

#ifndef MK_COOP
#define MK_COOP 1
#endif
extern "C" void kernel_launch(void* const* d_in, const int* in_sizes, int n_in, void* d_out, int out_size, void* d_ws, size_t ws_size, hipStream_t stream) {
    static int grid = 0;
    if (grid == 0) {
        if (n_in != 17 || out_size != M * DM || ws_size < WS_END) { fprintf(stderr, "kernel_launch: unexpected shapes (n_in %d out %d ws %zu)\n", n_in, out_size, ws_size); grid = -1; return; }
        int dev = 0, cus = 0, per_cu = 0;
        (void)hipGetDevice(&dev); (void)hipDeviceGetAttribute(&cus, hipDeviceAttributeMultiprocessorCount, dev);
        if (hipFuncSetAttribute((const void*)fwd_kernel, hipFuncAttributeMaxDynamicSharedMemorySize, LDS_BYTES) != hipSuccess) { fprintf(stderr, "kernel_launch: hipFuncSetAttribute failed\n"); grid = -1; return; }
        if (hipOccupancyMaxActiveBlocksPerMultiprocessor(&per_cu, (const void*)fwd_kernel, NTHREADS, LDS_BYTES) != hipSuccess || per_cu < 1) { fprintf(stderr, "kernel_launch: occupancy query says %d\n", per_cu); per_cu = 1; }
        (void)hipGetLastError();
        grid = cus > 0 ? cus : 256;
    }
    if (grid < 0) return;
    Params p{};
    for (int i = 0; i < 17; ++i) p.in[i] = (const float*)d_in[i];
    p.out = (float*)d_out; p.ws = (unsigned char*)d_ws;
#if MK_COOP
    p.ph_lo = 0; p.ph_hi = N_PHASES;
    void* args[] = {&p};
    hipError_t e = hipLaunchCooperativeKernel((const void*)fwd_kernel, dim3(grid), dim3(NTHREADS), args, LDS_BYTES, stream);
    if (e != hipSuccess) fprintf(stderr, "cooperative launch failed: %s (grid %d)\n", hipGetErrorString(e), grid);
#else
    for (int ph = 0; ph < N_PHASES; ++ph) {
        p.ph_lo = ph; p.ph_hi = ph + 1;
        hipLaunchKernelGGL(fwd_kernel, dim3(grid), dim3(NTHREADS), LDS_BYTES, stream, p);
    }
#endif
}
```

```cpp
#include <hip/hip_runtime.h>
#include <hip/hip_cooperative_groups.h>
#include <cstdio>
#include <cstdint>
namespace cg = cooperative_groups;
namespace pg8 {
#define PG8_LAS __attribute__((address_space(3)))
typedef unsigned short bf16_t;
typedef short bf16x8 __attribute__((ext_vector_type(8)));
typedef float f32x4 __attribute__((ext_vector_type(4)));
typedef unsigned u32x4 __attribute__((ext_vector_type(4)));
constexpr int BM = 256, BK = 64, HALF = 128, HTB = HALF * BK * 2  , STAGE_BYTES = 8 * HTB, NXCD = 8, WGM = 8;

__host__ __device__ __forceinline__ int lds_byte(int r, int c) { const int st = (r >> 4) * 2 + (c >> 5), rr = r & 15, cc = c & 31, ob = rr * 64 + cc * 2; return st * 1024 + (ob ^ (((ob >> 9) & 1) << 5)); }
__host__ __device__ __forceinline__ void stage_rc(int b, int& R, int& C) { const int st = b / 1024, sb = b % 1024, swz = sb ^ (((sb >> 9) & 1) << 5); R = (st >> 1) * 16 + swz / 64; C = (st & 1) * 32 + (swz % 64) / 2; }
__host__ __device__ __forceinline__ int perm32(int rho) { const int n = rho >> 4, i = rho & 15; return 8 * (i >> 2) + 4 * n + (i & 3); }

struct Unit { int pm, pn; };
struct Gemm { const bf16_t* A; const bf16_t* Bt; int M, N, K; };

struct StaticOrder {
    int nM, nN, nwg, G, c;
    __host__ __device__ void init(int M, int N, int G_, int c_) { nM = M / BM; nN = N / BM; nwg = nM * nN; G = G_; c = c_; }
    __host__ __device__ bool next(int i, Unit& u) const {
        const long L = (long)i * G + c; if (L >= nwg) return false;
        int wgid = (int)L; { const int q = nwg / NXCD, r = nwg % NXCD, xcd = wgid % NXCD, off = wgid / NXCD; wgid = (xcd < r ? xcd * (q + 1) : r * (q + 1) + (xcd - r) * q) + off; }
        const int nig = WGM * nN, gid = wgid / nig, fm = gid * WGM, gsz = (nM - fm) < WGM ? (nM - fm) : WGM;
        u.pm = fm + ((wgid % nig) % gsz); u.pn = (wgid % nig) / gsz; return true;
    }
    __device__ __forceinline__ void a_ready(const Unit&) const {}
    __device__ __forceinline__ void done(const Unit&) const {}
};

__device__ __forceinline__ unsigned cvt_pk_bf16(float lo, float hi) { unsigned r; asm volatile("v_cvt_pk_bf16_f32 %0, %1, %2" : "=v"(r) : "v"(lo), "v"(hi)); return r; }
typedef float f32x2 __attribute__((ext_vector_type(2)));
template <class Epi, class Sched, bool ALIGN_EPI = false, bool SP2 = false>
__device__ __forceinline__ void gemm_phase(PG8_LAS unsigned char* lds, const Gemm g, const Sched& S, const Epi& E, const int tid) {
    const int wid = __builtin_amdgcn_readfirstlane(tid >> 6), lane = tid & 63, wr = wid >> 2, wc = wid & 3, fr = lane & 15, fq = lane >> 4;
    const int K = g.K, nt = K / BK;
    unsigned voffA[2], voffB[2];
#pragma unroll
    for (int i = 0; i < 2; ++i) { int R, C; stage_rc(tid * 16 + i * 8192, R, C); const int Rb = Epi::PERM ? ((R & ~31) + perm32(R & 31)) : R;
        voffA[i] = (unsigned)(R * K + C) * 2u; voffB[i] = (unsigned)(Rb * K + C) * 2u; }
    const size_t kstep = (size_t)(BK * 2);
    const size_t hstep = (size_t)HALF * K * 2;
    const size_t tstep = 2 * hstep;
    const unsigned ldsw = (unsigned)wid * 1024u;
    const int aoff = lds_byte(wr * 64 + fr, fq * 8), boff = lds_byte(wc * 32 + fr, fq * 8);
#define PG8_SA(b, h) (((b) * 2 + (h)) * HTB)
#define PG8_SB(b, h) ((4 + (b) * 2 + (h)) * HTB)
#define PG8_STAGE(bufoff, gbase, voff) do { _Pragma("unroll") for (int _i = 0; _i < 2; ++_i) \
        __builtin_amdgcn_global_load_lds((const unsigned*)((const char*)(gbase) + (voff)[_i]), (PG8_LAS unsigned*)(lds + (bufoff) + ldsw + _i * 8192), 16, 0, 0); } while (0)
#define PG8_LDA(dst, b, h) do { _Pragma("unroll") for (int m = 0; m < 4; ++m) _Pragma("unroll") for (int k = 0; k < 2; ++k) dst[m][k] = *(const PG8_LAS bf16x8*)(lds + PG8_SA(b, h) + aoff + m * 2048 + k * 1024); } while (0)
#define PG8_LDB(dst, b, h) do { _Pragma("unroll") for (int n = 0; n < 2; ++n) _Pragma("unroll") for (int k = 0; k < 2; ++k) dst[n][k] = *(const PG8_LAS bf16x8*)(lds + PG8_SB(b, h) + boff + n * 2048 + k * 1024); } while (0)
#define PG8_MMA(ai, bj, At, Bt) do { __builtin_amdgcn_s_setprio(1); _Pragma("unroll") for (int m = 0; m < 4; ++m) _Pragma("unroll") for (int n = 0; n < 2; ++n) _Pragma("unroll") for (int k = 0; k < 2; ++k) \
        acc[ai][bj][m][n] = __builtin_amdgcn_mfma_f32_16x16x32_bf16(Bt[n][k], At[m][k], acc[ai][bj][m][n], 0, 0, 0); __builtin_amdgcn_s_setprio(0); } while (0)
#define PG8_WAIT_V(n) asm volatile("s_waitcnt vmcnt(" #n ")" ::: "memory")
#define PG8_WAIT_L(n) asm volatile("s_waitcnt lgkmcnt(" #n ")" ::: "memory")
#define PG8_BAR __builtin_amdgcn_s_barrier()
#define PG8_SCHED __builtin_amdgcn_sched_barrier(0)
    Unit cur, nxt; int ui = 0;
    if (!S.next(0, cur)) return;
    f32x4 acc[2][2][4][2];
#pragma unroll
    for (int a = 0; a < 2; ++a)
#pragma unroll
        for (int b = 0; b < 2; ++b)
#pragma unroll
            for (int m = 0; m < 4; ++m)
#pragma unroll
                for (int n = 0; n < 2; ++n) acc[a][b][m][n] = (f32x4){0.f, 0.f, 0.f, 0.f};
    bf16x8 At[4][2], B0[2][2], B1[2][2];
    const char* cA = (const char*)g.A + (size_t)cur.pm * tstep; const char* cB = (const char*)g.Bt + (size_t)cur.pn * tstep;
    S.a_ready(cur);
    if constexpr (SP2) {
        PG8_STAGE(PG8_SB(0, 0), cB, voffB); PG8_STAGE(PG8_SB(0, 1), cB + hstep, voffB); PG8_STAGE(PG8_SA(0, 0), cA, voffA); PG8_STAGE(PG8_SA(0, 1), cA + hstep, voffA);
        if (wr == 1) PG8_BAR;
        PG8_WAIT_V(2); PG8_BAR;
        PG8_STAGE(PG8_SB(1, 0), cB + kstep, voffB); PG8_STAGE(PG8_SA(1, 0), cA + kstep, voffA); PG8_STAGE(PG8_SB(1, 1), cB + hstep + kstep, voffB);
        PG8_WAIT_V(6); PG8_BAR;
    } else {
        PG8_STAGE(PG8_SB(0, 0), cB, voffB); PG8_STAGE(PG8_SA(0, 0), cA, voffA); PG8_STAGE(PG8_SB(0, 1), cB + hstep, voffB); PG8_STAGE(PG8_SA(0, 1), cA + hstep, voffA);
        if (wr == 1) PG8_BAR;
        PG8_WAIT_V(4); PG8_BAR;
        PG8_STAGE(PG8_SB(1, 0), cB + kstep, voffB); PG8_STAGE(PG8_SA(1, 0), cA + kstep, voffA); PG8_STAGE(PG8_SB(1, 1), cB + hstep + kstep, voffB);
        PG8_WAIT_V(6); PG8_BAR;
    }
    for (;;) {
        const bool has_next = S.next(ui + 1, nxt);
        const char* nA = has_next ? (const char*)g.A + (size_t)nxt.pm * tstep : cA; const char* nB = has_next ? (const char*)g.Bt + (size_t)nxt.pn * tstep : cB;
        for (int t = 0; t < nt; t += 2) {
            const bool last = (t == nt - 2);
            const char* a1 = cA + (size_t)(t + 1) * kstep;
            const char* a2 = last ? nA : cA + (size_t)(t + 2) * kstep; const char* b2 = last ? nB : cB + (size_t)(t + 2) * kstep;
            const char* a3 = a2 + kstep; const char* b3 = b2 + kstep;
            if (last && has_next) S.a_ready(nxt);
            if constexpr (SP2) {
            PG8_LDB(B0, 0, 0); PG8_LDB(B1, 0, 1); PG8_SCHED; PG8_LDA(At, 0, 0); PG8_STAGE(PG8_SA(1, 1), a1 + hstep, voffA);
            PG8_WAIT_V(8); PG8_WAIT_L(0); PG8_BAR; PG8_MMA(0, 0, At, B0); PG8_MMA(0, 1, At, B1); PG8_BAR; PG8_SCHED;
            PG8_LDA(At, 0, 1); PG8_STAGE(PG8_SB(0, 0), b2, voffB); PG8_STAGE(PG8_SB(0, 1), b2 + hstep, voffB); PG8_STAGE(PG8_SA(0, 0), a2, voffA);
            PG8_WAIT_V(8); PG8_WAIT_L(0); PG8_BAR; PG8_MMA(1, 0, At, B0); PG8_MMA(1, 1, At, B1); PG8_BAR; PG8_SCHED;
            PG8_LDB(B0, 1, 0); PG8_LDB(B1, 1, 1); PG8_SCHED; PG8_LDA(At, 1, 0); PG8_STAGE(PG8_SA(0, 1), a2 + hstep, voffA);
            PG8_WAIT_V(8); PG8_WAIT_L(0); PG8_BAR; PG8_MMA(0, 0, At, B0); PG8_MMA(0, 1, At, B1); PG8_BAR; PG8_SCHED;
            PG8_LDA(At, 1, 1); PG8_STAGE(PG8_SB(1, 0), b3, voffB); PG8_STAGE(PG8_SB(1, 1), b3 + hstep, voffB); PG8_STAGE(PG8_SA(1, 0), a3, voffA);
            PG8_WAIT_V(8); PG8_WAIT_L(0); PG8_BAR; PG8_MMA(1, 0, At, B0); PG8_MMA(1, 1, At, B1); PG8_BAR; PG8_SCHED;
            } else {
            PG8_LDB(B0, 0, 0); PG8_SCHED; PG8_LDA(At, 0, 0); PG8_STAGE(PG8_SA(1, 1), a1 + hstep, voffA);
            PG8_WAIT_L(8); PG8_BAR; PG8_WAIT_L(0); PG8_MMA(0, 0, At, B0); PG8_BAR; PG8_SCHED;
            PG8_LDB(B1, 0, 1); PG8_STAGE(PG8_SB(0, 0), b2, voffB);
            PG8_BAR; PG8_WAIT_L(0); PG8_MMA(0, 1, At, B1); PG8_BAR;
            PG8_LDA(At, 0, 1); PG8_STAGE(PG8_SA(0, 0), a2, voffA);
            PG8_BAR; PG8_WAIT_L(0); PG8_MMA(1, 0, At, B0); PG8_BAR; PG8_SCHED;
            PG8_STAGE(PG8_SB(0, 1), b2 + hstep, voffB);
            PG8_WAIT_V(6); PG8_BAR; PG8_MMA(1, 1, At, B1); PG8_BAR;
            PG8_LDB(B0, 1, 0); PG8_SCHED; PG8_LDA(At, 1, 0); PG8_STAGE(PG8_SA(0, 1), a2 + hstep, voffA);
            PG8_WAIT_L(8); PG8_BAR; PG8_WAIT_L(0); PG8_MMA(0, 0, At, B0); PG8_BAR; PG8_SCHED;
            PG8_LDB(B1, 1, 1); PG8_STAGE(PG8_SB(1, 0), b3, voffB);
            PG8_BAR; PG8_WAIT_L(0); PG8_MMA(0, 1, At, B1); PG8_BAR;
            PG8_LDA(At, 1, 1); PG8_STAGE(PG8_SA(1, 0), a3, voffA);
            PG8_BAR; PG8_WAIT_L(0); PG8_MMA(1, 0, At, B0); PG8_BAR; PG8_SCHED;
            PG8_STAGE(PG8_SB(1, 1), b3 + hstep, voffB);
            PG8_WAIT_V(6); PG8_BAR; PG8_MMA(1, 1, At, B1); PG8_BAR;
            }
        }
        if constexpr (ALIGN_EPI) { if (wr == 0) PG8_BAR; }
        if constexpr (!Epi::AFTER_DRAIN) { E(acc, cur, wr, wc, fr, fq); S.done(cur); }
        if (!has_next) break;
#pragma unroll
        for (int a = 0; a < 2; ++a)
#pragma unroll
            for (int b = 0; b < 2; ++b)
#pragma unroll
                for (int m = 0; m < 4; ++m)
#pragma unroll
                    for (int n = 0; n < 2; ++n) acc[a][b][m][n] = (f32x4){0.f, 0.f, 0.f, 0.f};
        cur = nxt; cA = nA; cB = nB; ++ui;
        if constexpr (ALIGN_EPI) { if (wr == 1) PG8_BAR; }
    }
    PG8_WAIT_V(0);
    if constexpr (!ALIGN_EPI) { if (wr == 0) PG8_BAR; }
    PG8_BAR;
    if constexpr (Epi::AFTER_DRAIN) { E.fused(acc, cur, wr, wc, fr, fq, lds, wid, lane); S.done(cur); }
#undef PG8_SA
#undef PG8_SB
#undef PG8_STAGE
#undef PG8_LDA
#undef PG8_LDB
#undef PG8_MMA
#undef PG8_WAIT_V
#undef PG8_WAIT_L
#undef PG8_BAR
#undef PG8_SCHED
}
}

#ifndef NSA_ZERO
#define NSA_ZERO 0
#endif

#define LAS __attribute__((address_space(3)))
typedef unsigned short bf16_t;
typedef short bf16x8 __attribute__((ext_vector_type(8)));
typedef short bf16x4 __attribute__((ext_vector_type(4)));
typedef float f32x4 __attribute__((ext_vector_type(4)));
typedef unsigned u32x4 __attribute__((ext_vector_type(4)));
typedef unsigned u32x2 __attribute__((ext_vector_type(2)));

constexpr int BATCH = 32, T = 2048, M = BATCH * T, DM = 1024, DEPTH = 2;
constexpr int NPROJ = 3584, INW = 3352, DFF = 2816;
constexpr int C_HQ = 0, C_HF = 512, C_HI = 1024, C_HG = 1536, C_NQ = 2048, C_KC = 2560, C_VC = 2688, C_KS = 2816, C_VS = 2944, C_KW = 3072, C_VW = 3200, C_GT = 3328;
constexpr float RMS_EPS = 1e-6f;
constexpr size_t MiB = 1u << 20;
constexpr size_t WS_CTL = 0, WS_WIN = 1 * MiB, WS_WOUT = 15 * MiB, WS_WFFI = 19 * MiB, WS_WFFO = 41 * MiB, WS_W1T = 52 * MiB, WS_W2T = 56 * MiB;
constexpr size_t WS_XN = 64 * MiB, WS_MIX = 192 * MiB, WS_LOGF = 320 * MiB, WS_PROJ = 448 * MiB, WS_QN = 896 * MiB;
constexpr size_t WS_KS = WS_XN, WS_KW = WS_XN + 16 * MiB, WS_VST = WS_XN + 32 * MiB, WS_VWT = WS_XN + 48 * MiB, WS_KC = WS_XN + 64 * MiB, WS_VCT = WS_XN + 65 * MiB, WS_END = 960 * MiB;
constexpr int LDS_BYTES = 143360;
constexpr int NTHREADS = 512;

struct Params { const float* in[17]; float* out; unsigned char* ws; int ph_lo, ph_hi; unsigned char prog[48]; };

__device__ __forceinline__ float bf2f(bf16_t v) { return __uint_as_float(((unsigned)v) << 16); }
__device__ __forceinline__ unsigned pk2(float lo, float hi) { unsigned r; asm("v_cvt_pk_bf16_f32 %0, %1, %2" : "=v"(r) : "v"(lo), "v"(hi)); return r; }
__device__ __forceinline__ bf16_t f2bf(float f) { return (bf16_t)(pk2(f, 0.f) & 0xffffu); }
__device__ __forceinline__ float wave_sum(float v) {
#pragma unroll
    for (int o = 1; o < 64; o <<= 1) v += __shfl_xor(v, o);
    return v;
}
__device__ __forceinline__ float fast_sigmoid(float x) { return __builtin_amdgcn_rcpf(1.f + __expf(-x)); }
__device__ __forceinline__ float fast_silu(float x) { return x * fast_sigmoid(x); }
#define LDS_WAIT() asm volatile("s_waitcnt lgkmcnt(0)" ::: "memory")
#define LDS_BARRIER() do { asm volatile("s_waitcnt lgkmcnt(0)" ::: "memory"); __builtin_amdgcn_s_barrier(); asm volatile("" ::: "memory"); } while (0)
#define MFMA16(a, b, c) __builtin_amdgcn_mfma_f32_16x16x32_bf16((a), (b), (c), 0, 0, 0)

struct EpiProj {
    static constexpr bool PERM = true, AFTER_DRAIN = false;
    bf16_t* P; float* LOGF; const float* lb;
    __device__ __forceinline__ void operator()(const f32x4 (&acc)[2][2][4][2], const pg8::Unit& u, int wr, int wc, int fr, int fq) const {
        const int row0 = u.pm * 256 + wr * 64 + fr;
        const int col0 = u.pn * 256 + wc * 32 + 8 * fq;
        if (u.pn == 2 || u.pn == 3) {
#pragma unroll
            for (int bj = 0; bj < 2; ++bj) {
                const int cc = col0 + bj * 128 - C_HF;
                const f32x4 l0 = *(const f32x4*)(lb + cc), l1 = *(const f32x4*)(lb + cc + 4);
#pragma unroll
                for (int ai = 0; ai < 2; ++ai)
#pragma unroll
                    for (int m = 0; m < 4; ++m) {
                        const f32x4 z0 = acc[ai][bj][m][0], z1 = acc[ai][bj][m][1];
                        f32x4 o0, o1;
#pragma unroll
                        for (int e = 0; e < 4; ++e) {
                            const float s0 = 1.f / (1.f + expf(-z0[e])), s1 = 1.f / (1.f + expf(-z1[e]));
                            o0[e] = logf(l0[e] + (1.f - l0[e]) * s0); o1[e] = logf(l1[e] + (1.f - l1[e]) * s1);
                        }
                        float* dst = LOGF + (size_t)(row0 + ai * 128 + m * 16) * 512 + cc;
                        *(f32x4*)dst = o0; *(f32x4*)(dst + 4) = o1;
                    }
            }
        } else {
#pragma unroll
            for (int ai = 0; ai < 2; ++ai)
#pragma unroll
                for (int m = 0; m < 4; ++m) {
                    bf16_t* rowp = P + (size_t)(row0 + ai * 128 + m * 16) * NPROJ + col0;
#pragma unroll
                    for (int bj = 0; bj < 2; ++bj) {
                        const f32x4 v0 = acc[ai][bj][m][0], v1 = acc[ai][bj][m][1];
                        u32x4 w; w.x = pk2(v0[0], v0[1]); w.y = pk2(v0[2], v0[3]); w.z = pk2(v1[0], v1[1]); w.w = pk2(v1[2], v1[3]);
                        *(u32x4*)(rowp + bj * 128) = w;
                    }
                }
        }
    }
};
struct EpiRes {
    static constexpr bool PERM = true, AFTER_DRAIN = false;
    const float* base; float* out;
    __device__ __forceinline__ void operator()(const f32x4 (&acc)[2][2][4][2], const pg8::Unit& u, int wr, int wc, int fr, int fq) const {
        const int row0 = u.pm * 256 + wr * 64 + fr;
        const int col0 = u.pn * 256 + wc * 32 + 8 * fq;
#pragma unroll
        for (int ai = 0; ai < 2; ++ai)
#pragma unroll
            for (int m = 0; m < 4; ++m) {
                const size_t off = (size_t)(row0 + ai * 128 + m * 16) * DM + col0;
#pragma unroll
                for (int bj = 0; bj < 2; ++bj) {
                    const f32x4 b0 = *(const f32x4*)(base + off + bj * 128), b1 = *(const f32x4*)(base + off + bj * 128 + 4);
                    *(f32x4*)(out + off + bj * 128) = b0 + acc[ai][bj][m][0];
                    *(f32x4*)(out + off + bj * 128 + 4) = b1 + acc[ai][bj][m][1];
                }
            }
    }
};
struct EpiSwiGLU {
    static constexpr bool PERM = true, AFTER_DRAIN = false;
    bf16_t* A;
    __device__ __forceinline__ void operator()(const f32x4 (&acc)[2][2][4][2], const pg8::Unit& u, int wr, int wc, int fr, int fq) const {
        const int row0 = u.pm * 256 + wr * 64 + fr;
        const int col0 = u.pn * 128 + wc * 32 + 8 * fq;
#pragma unroll
        for (int ai = 0; ai < 2; ++ai)
#pragma unroll
            for (int m = 0; m < 4; ++m) {
                const f32x4 g0 = acc[ai][0][m][0], g1 = acc[ai][0][m][1], u0 = acc[ai][1][m][0], u1 = acc[ai][1][m][1];
                float r[8];
#pragma unroll
                for (int e = 0; e < 4; ++e) { r[e] = fast_silu(g0[e]) * u0[e]; r[4 + e] = fast_silu(g1[e]) * u1[e]; }
                u32x4 w; w.x = pk2(r[0], r[1]); w.y = pk2(r[2], r[3]); w.z = pk2(r[4], r[5]); w.w = pk2(r[6], r[7]);
                *(u32x4*)(A + (size_t)(row0 + ai * 128 + m * 16) * DFF + col0) = w;
            }
    }
};

__device__ __forceinline__ void transpose_item(const float* __restrict__ W, int K, int N, int nblk, bf16_t* WT, int mode, LAS float* scr, int item, int lane) {
    const int kb = item / nblk, nb = item % nblk, k0 = 64 * kb, n0 = 32 * nb;
    const int n = n0 + (lane & 31);
#pragma unroll 8
    for (int i = 0; i < 32; ++i) { const int kk = 2 * i + (lane >> 5); scr[kk * 33 + (lane & 31)] = (n < N) ? W[(size_t)(k0 + kk) * N + n] : 0.f; }
    LDS_WAIT();
    const int c = lane & 7;
#pragma unroll
    for (int j = 0; j < 4; ++j) {
        const int nl = (lane >> 3) + 8 * j, nn = n0 + nl;
        int row = nn;
        if (mode == 1) row = (nn < DFF) ? ((nn >> 7) * 256 + (nn & 127)) : ((((nn - DFF) >> 7) * 256) + 128 + ((nn - DFF) & 127));
        const LAS float* s = scr + (8 * c) * 33 + nl;
        u32x4 o; o.x = pk2(s[0 * 33], s[1 * 33]); o.y = pk2(s[2 * 33], s[3 * 33]); o.z = pk2(s[4 * 33], s[5 * 33]); o.w = pk2(s[6 * 33], s[7 * 33]);
        *(u32x4*)(WT + (size_t)row * K + k0 + 8 * c) = o;
    }
    LDS_WAIT();
}
__device__ __forceinline__ void rms_row_to_bf16(const float* xrow, const float* gain, bf16_t* orow, int lane) {
    const f32x4* xr = (const f32x4*)xrow + lane;
    const f32x4* gr = (const f32x4*)gain + lane;
    f32x4 v[4]; float s = 0.f;
#pragma unroll
    for (int j = 0; j < 4; ++j) { v[j] = xr[64 * j]; s += (v[j].x * v[j].x + v[j].y * v[j].y) + (v[j].z * v[j].z + v[j].w * v[j].w); }
    const float rstd = 1.f / sqrtf(wave_sum(s) * (1.f / DM) + RMS_EPS);
    unsigned long long* o8 = (unsigned long long*)orow + lane;
#pragma unroll
    for (int j = 0; j < 4; ++j) { const f32x4 g = gr[64 * j];
        o8[64 * j] = (unsigned long long)pk2(v[j].x * rstd * g.x, v[j].y * rstd * g.y) | ((unsigned long long)pk2(v[j].z * rstd * g.z, v[j].w * rstd * g.w) << 32); }
}
__device__ __forceinline__ void norm_phase(const float* src, const float* gain, bf16_t* XN, int gw, int NGW, int lane) {
    for (int m = gw; m < M; m += NGW) rms_row_to_bf16(src + (size_t)m * DM, gain, XN + (size_t)m * DM, lane);
}
__device__ __forceinline__ void prologue_phase(const Params& p, LAS unsigned char* lds, int gw, int NGW, int wave, int lane) {
    LAS float* scr = (LAS float*)(lds + wave * 16384);
    unsigned char* ws = p.ws;
    constexpr int I_IN = 16 * 112, I_OUT = 16 * 32, I_FFI = 16 * 176, I_FFO = 44 * 32, I_W1 = 32 * 8, I_W2 = 4 * 2;
    constexpr int PER_LAYER = I_IN + I_OUT + I_FFI + I_FFO + 2 * I_W1 + 2 * I_W2;
    for (int it = gw; it < DEPTH * PER_LAYER; it += NGW) {
        const int l = it / PER_LAYER; int r = it % PER_LAYER;
        if (r < I_IN) { transpose_item(p.in[1] + (size_t)l * DM * INW, DM, INW, 112, (bf16_t*)(ws + WS_WIN) + (size_t)l * NPROJ * DM, 0, scr, r, lane); continue; } r -= I_IN;
        if (r < I_OUT) { transpose_item(p.in[2] + (size_t)l * DM * DM, DM, DM, 32, (bf16_t*)(ws + WS_WOUT) + (size_t)l * DM * DM, 0, scr, r, lane); continue; } r -= I_OUT;
        if (r < I_FFI) { transpose_item(p.in[13] + (size_t)l * DM * 2 * DFF, DM, 2 * DFF, 176, (bf16_t*)(ws + WS_WFFI) + (size_t)l * 2 * DFF * DM, 1, scr, r, lane); continue; } r -= I_FFI;
        if (r < I_FFO) { transpose_item(p.in[14] + (size_t)l * DFF * DM, DFF, DM, 32, (bf16_t*)(ws + WS_WFFO) + (size_t)l * DM * DFF, 0, scr, r, lane); continue; } r -= I_FFO;
        if (r < I_W1) { transpose_item(p.in[8] + (size_t)l * 2048 * 256, 2048, 256, 8, (bf16_t*)(ws + WS_W1T) + (size_t)(l * 2 + 0) * 256 * 2048, 0, scr, r, lane); continue; } r -= I_W1;
        if (r < I_W1) { transpose_item(p.in[11] + (size_t)l * 2048 * 256, 2048, 256, 8, (bf16_t*)(ws + WS_W1T) + (size_t)(l * 2 + 1) * 256 * 2048, 0, scr, r, lane); continue; } r -= I_W1;
        if (r < I_W2) { transpose_item(p.in[9] + (size_t)l * 256 * 64, 256, 64, 2, (bf16_t*)(ws + WS_W2T) + (size_t)(l * 2 + 0) * 64 * 256, 0, scr, r, lane); continue; } r -= I_W2;
        transpose_item(p.in[12] + (size_t)l * 256 * 64, 256, 64, 2, (bf16_t*)(ws + WS_W2T) + (size_t)(l * 2 + 1) * 64 * 256, 0, scr, r, lane);
    }
    if (gw == 0) {
        unsigned* ctl = (unsigned*)(ws + WS_CTL);
        if (lane < 48) ctl[64 * lane] = 0u;
        float* LB = (float*)(ws + WS_CTL + 16384);
        for (int c = lane; c < 512; c += 64) { const float l0 = p.in[3][c], l1 = p.in[3][512 + c]; LB[c] = 0.f; LB[512 + c] = 1.f / (1.f + expf(l0 - l1)); }
    }
    norm_phase(p.in[0], p.in[15], (bf16_t*)(ws + WS_XN), gw, NGW, lane);
}

constexpr float ROPE_C = 0.41524101186092034f;
constexpr float QSCALE = 0.125f * 1.4426950408889634f;
__device__ __forceinline__ void prep_item(const Params& p, int l, int item, LAS unsigned char* lds, int tid, int wave, int lane) {
    const int b = item >> 5, tc = item & 31, m0 = b * T + tc * 64;
    unsigned char* ws = p.ws;
    const bf16_t* PROJ = (const bf16_t*)(ws + WS_PROJ);
    LAS bf16_t* Vt = (LAS bf16_t*)lds;
#pragma unroll
    for (int k = 0; k < 4; ++k) {
        const int c = tid + 512 * k, token = c >> 5, part = c & 31;
        const int col = part < 16 ? C_VS + part * 8 : C_VW + (part - 16) * 8;
        const u32x4 v = *(const u32x4*)(PROJ + (size_t)(m0 + token) * NPROJ + col);
        *(LAS u32x4*)(Vt + token * 264 + part * 8) = v;
    }
    {
        const int i = lane & 31, hf = lane >> 5;
        const float freq = exp2f(-(float)i * ROPE_C);
        const float* qg = p.in[5] + l * 64; const float* kg = p.in[6] + l * 192;
        const float gq1 = qg[i], gq2 = qg[i + 32], gs1 = kg[64 + i], gs2 = kg[96 + i], gw1 = kg[128 + i], gw2 = kg[160 + i];
        bf16_t* QN = (bf16_t*)(ws + WS_QN); bf16_t* KS = (bf16_t*)(ws + WS_KS); bf16_t* KW = (bf16_t*)(ws + WS_KW);
        for (int tl = 0; tl < 8; ++tl) {
            const int token = 8 * wave + tl, t = tc * 64 + token;
            float sn, cs; sincosf((float)t * freq, &sn, &cs);
            const bf16_t* row = PROJ + (size_t)(m0 + token) * NPROJ;
#pragma unroll
            for (int k = 0; k < 6; ++k) {
                const int hd = 2 * k + hf;
                const int col = hd < 8 ? C_NQ + hd * 64 : (hd < 10 ? C_KS + (hd - 8) * 64 : C_KW + (hd - 10) * 64);
                const float x1 = bf2f(row[col + i]), x2 = bf2f(row[col + 32 + i]);
                float ss = x1 * x1 + x2 * x2;
                ss += __shfl_xor(ss, 1); ss += __shfl_xor(ss, 2); ss += __shfl_xor(ss, 4); ss += __shfl_xor(ss, 8); ss += __shfl_xor(ss, 16);
                const float rstd = 1.f / sqrtf(ss * (1.f / 64.f) + RMS_EPS);
                const float g1 = hd < 8 ? gq1 : (hd < 10 ? gs1 : gw1), g2 = hd < 8 ? gq2 : (hd < 10 ? gs2 : gw2);
                const float sc = hd < 8 ? QSCALE : 1.f;
                const float y1 = x1 * rstd * g1, y2 = x2 * rstd * g2;
                const float o1 = (y1 * cs - y2 * sn) * sc, o2 = (y1 * sn + y2 * cs) * sc;
                bf16_t* dst;
                if (hd < 8) dst = QN + (((size_t)(b * 2 + (hd >> 2)) * T + t) * 4 + (hd & 3)) * 64;
                else if (hd < 10) dst = KS + ((size_t)(b * 2 + (hd - 8)) * T + t) * 64;
                else dst = KW + ((size_t)(b * 2 + (hd - 10)) * T + t) * 64;
                dst[i] = f2bf(o1); dst[i + 32] = f2bf(o2);
            }
        }
    }
    __syncthreads();
    {
        const int r = tid >> 1, h2 = tid & 1, typ = r >> 7, g = (r >> 6) & 1, d = r & 63;
        bf16_t* dst = (bf16_t*)(ws + (typ ? WS_VWT : WS_VST)) + (((size_t)(b * 2 + g) * 32 + tc) * 64 + d) * 64 + 32 * h2;
#pragma unroll
        for (int q4 = 0; q4 < 4; ++q4) {
            unsigned w[4];
#pragma unroll
            for (int k = 0; k < 4; ++k) {
                const unsigned lo = Vt[(32 * h2 + 8 * q4 + 2 * k) * 264 + r], hi = Vt[(32 * h2 + 8 * q4 + 2 * k + 1) * 264 + r];
                w[k] = lo | (hi << 16);
            }
            *(u32x4*)(dst + 8 * q4) = (u32x4){w[0], w[1], w[2], w[3]};
        }
    }
    __syncthreads();
}

__device__ __forceinline__ void compress_item(const Params& p, int l, int ci, LAS unsigned char* lds, int tid, int wave, int lane) {
    const int half = ci & 1, kv = (ci >> 1) & 1, bg = ci >> 2, b = bg >> 1, g = bg & 1;
    const int quad = lane >> 4, r16 = lane & 15;
    unsigned char* ws = p.ws;
    const bf16_t* src = (const bf16_t*)(ws + WS_PROJ) + (size_t)b * T * NPROJ + (kv ? C_VC : C_KC) + g * 64;
    const float* pe = p.in[kv ? 10 : 7] + l * 32 * 64;
    const bf16_t* W1T = (const bf16_t*)(ws + WS_W1T) + (size_t)(l * 2 + kv) * 256 * 2048;
    const bf16_t* W2T = (const bf16_t*)(ws + WS_W2T) + (size_t)(l * 2 + kv) * 64 * 256;
    LAS bf16_t* As = (LAS bf16_t*)lds;
    LAS bf16_t* Bs = (LAS bf16_t*)(lds + 9216);
    LAS bf16_t* Hs = (LAS bf16_t*)(lds + 46080);
    LAS float* Os = (LAS float*)(lds + 79872);
    f32x4 acc[4][2];
#pragma unroll
    for (int mt = 0; mt < 4; ++mt) { acc[mt][0] = (f32x4){0.f, 0.f, 0.f, 0.f}; acc[mt][1] = (f32x4){0.f, 0.f, 0.f, 0.f}; }
    const int ar = tid >> 3, ach = tid & 7, n_a = 64 * half + ar;
    for (int ls = 0; ls < 32; ++ls) {
        int tok = 16 * n_a + ls; tok = tok > T - 1 ? T - 1 : tok;
        const u32x4 raw = *(const u32x4*)(src + (size_t)tok * NPROJ + ach * 8);
        const f32x4 pe0 = *(const f32x4*)(pe + ls * 64 + ach * 8), pe1 = *(const f32x4*)(pe + ls * 64 + ach * 8 + 4);
        u32x4 o;
        o.x = pk2(__uint_as_float(raw.x << 16) + pe0[0], __uint_as_float(raw.x & 0xffff0000u) + pe0[1]);
        o.y = pk2(__uint_as_float(raw.y << 16) + pe0[2], __uint_as_float(raw.y & 0xffff0000u) + pe0[3]);
        o.z = pk2(__uint_as_float(raw.z << 16) + pe1[0], __uint_as_float(raw.z & 0xffff0000u) + pe1[1]);
        o.w = pk2(__uint_as_float(raw.w << 16) + pe1[2], __uint_as_float(raw.w & 0xffff0000u) + pe1[3]);
        *(LAS u32x4*)(As + ar * 72 + ach * 8) = o;
#pragma unroll
        for (int k = 0; k < 4; ++k) {
            const int j = ar + 64 * k;
            const u32x4 wv = *(const u32x4*)(W1T + (size_t)j * 2048 + ls * 64 + ach * 8);
            *(LAS u32x4*)(Bs + j * 72 + ach * 8) = wv;
        }
        __syncthreads();
#pragma unroll
        for (int kb = 0; kb < 2; ++kb) {
            bf16x8 bfr[2];
#pragma unroll
            for (int nt = 0; nt < 2; ++nt) bfr[nt] = *(const LAS bf16x8*)(Bs + (32 * wave + 16 * nt + r16) * 72 + 32 * kb + 8 * quad);
#pragma unroll
            for (int mt = 0; mt < 4; ++mt) {
                const bf16x8 a = *(const LAS bf16x8*)(As + (16 * mt + r16) * 72 + 32 * kb + 8 * quad);
#pragma unroll
                for (int nt = 0; nt < 2; ++nt) acc[mt][nt] = MFMA16(a, bfr[nt], acc[mt][nt]);
            }
        }
        __syncthreads();
    }
#pragma unroll
    for (int mt = 0; mt < 4; ++mt)
#pragma unroll
        for (int nt = 0; nt < 2; ++nt)
#pragma unroll
            for (int e = 0; e < 4; ++e) { const float x = acc[mt][nt][e]; Hs[(16 * mt + 4 * quad + e) * 264 + 32 * wave + 16 * nt + r16] = f2bf(x / (1.f + expf(-x))); }
    __syncthreads();
    {
        const int mt = wave >> 1;
        f32x4 o2[2]; o2[0] = (f32x4){0.f, 0.f, 0.f, 0.f}; o2[1] = (f32x4){0.f, 0.f, 0.f, 0.f};
#pragma unroll
        for (int kb = 0; kb < 8; ++kb) {
            const bf16x8 a = *(const LAS bf16x8*)(Hs + (16 * mt + r16) * 264 + 32 * kb + 8 * quad);
#pragma unroll
            for (int dd = 0; dd < 2; ++dd) {
                const int dt = 2 * (wave & 1) + dd;
                const bf16x8 bw = *(const bf16x8*)(W2T + (size_t)(16 * dt + r16) * 256 + 32 * kb + 8 * quad);
                o2[dd] = MFMA16(a, bw, o2[dd]);
            }
        }
#pragma unroll
        for (int dd = 0; dd < 2; ++dd)
#pragma unroll
            for (int e = 0; e < 4; ++e) Os[(16 * mt + 4 * quad + e) * 65 + 16 * (2 * (wave & 1) + dd) + r16] = o2[dd][e];
    }
    __syncthreads();
    if (kv == 0) {
        const int row = tid >> 3, sub = tid & 7, n = 64 * half + row;
        float x1[4], x2[4], ss = 0.f;
#pragma unroll
        for (int k = 0; k < 4; ++k) { x1[k] = Os[row * 65 + 4 * sub + k]; x2[k] = Os[row * 65 + 32 + 4 * sub + k]; ss += x1[k] * x1[k] + x2[k] * x2[k]; }
        ss += __shfl_xor(ss, 1); ss += __shfl_xor(ss, 2); ss += __shfl_xor(ss, 4);
        const float rstd = 1.f / sqrtf(ss * (1.f / 64.f) + RMS_EPS);
        const float* kg = p.in[6] + l * 192;
        const float pos = (float)(16 * n + 31);
        bf16_t* dst = (bf16_t*)(ws + WS_KC) + ((size_t)bg * 128 + n) * 64;
#pragma unroll
        for (int k = 0; k < 4; ++k) {
            const int i = 4 * sub + k;
            float sn, cs; sincosf(pos * exp2f(-(float)i * ROPE_C), &sn, &cs);
            const float y1 = x1[k] * rstd * kg[i], y2 = x2[k] * rstd * kg[i + 32];
            float o1 = y1 * cs - y2 * sn, o2v = y1 * sn + y2 * cs;
            if (n >= 127) { o1 = 0.f; o2v = 0.f; }
            dst[i] = f2bf(o1); dst[i + 32] = f2bf(o2v);
        }
    } else {
        const int d = tid >> 3, sub = tid & 7;
        float v[8];
#pragma unroll
        for (int k = 0; k < 8; ++k) { const int r = 8 * sub + k, n = 64 * half + r; v[k] = (n >= 127) ? 0.f : Os[r * 65 + d]; }
        u32x4 o; o.x = pk2(v[0], v[1]); o.y = pk2(v[2], v[3]); o.z = pk2(v[4], v[5]); o.w = pk2(v[6], v[7]);
        *(u32x4*)((bf16_t*)(ws + WS_VCT) + ((size_t)bg * 64 + d) * 128 + 64 * half + 8 * sub) = o;
    }
    __syncthreads();
}

__device__ __forceinline__ void hgrn_item(const Params& p, int l, int item, LAS unsigned char* lds, int tid, int wave, int lane) {
    const int b = item >> 2, h = item & 3;
    const int quad = lane >> 4, r16 = lane & 15;
    unsigned char* ws = p.ws;
    const bf16_t* PROJ = (const bf16_t*)(ws + WS_PROJ);
    const float* LOGF = (const float*)(ws + WS_LOGF);
    bf16_t* MIX = (bf16_t*)(ws + WS_MIX);
    const float* gnorm = p.in[4] + l * 128;
    LAS bf16_t* Qt = (LAS bf16_t*)lds;
    LAS bf16_t* Kt = (LAS bf16_t*)(lds + 17408);
    LAS float* Ob = (LAS float*)lds;
    LAS bf16_t* Qh = (LAS bf16_t*)(lds + 34816);
    LAS bf16_t* KhT = (LAS bf16_t*)(lds + 52224);
    LAS bf16_t* VT = (LAS bf16_t*)(lds + 70656);
    LAS bf16_t* As = (LAS bf16_t*)(lds + 89088);
    LAS bf16_t* ST = (LAS bf16_t*)(lds + 98304);
    LAS float* TOT = (LAS float*)(lds + 133120);
    LAS float* DEC = (LAS float*)(lds + 135168);
    const int d = tid & 127, seg = tid >> 7;
    for (int i = tid; i < 34816 / 16; i += NTHREADS) ((LAS u32x4*)ST)[i] = (u32x4){0u, 0u, 0u, 0u};
    f32x4 S[8];
#pragma unroll
    for (int vt = 0; vt < 8; ++vt) S[vt] = (f32x4){0.f, 0.f, 0.f, 0.f};
    __syncthreads();
    for (int c = 0; c < 32; ++c) {
        const int m0 = b * T + c * 64;
        float bl[16], qs[16], lf[16];
        {
            float cum = 0.f;
#pragma unroll
            for (int r = 0; r < 16; ++r) {
                const int row = seg * 16 + r;
                const bf16_t* pr = PROJ + (size_t)(m0 + row) * NPROJ + h * 128 + d;
                lf[r] = LOGF[(size_t)(m0 + row) * 512 + h * 128 + d];
                const float q = bf2f(pr[C_HQ]);
                qs[r] = q / (1.f + __expf(-q));
                VT[d * 72 + row] = pr[C_HI];
                cum += lf[r]; bl[r] = cum;
            }
            TOT[seg * 128 + d] = cum;
        }
        __syncthreads();
        {
            const float t0 = TOT[d], t1 = TOT[128 + d], t2 = TOT[256 + d], t3 = TOT[384 + d];
            const float off = seg == 0 ? 0.f : (seg == 1 ? t0 : (seg == 2 ? t0 + t1 : t0 + t1 + t2));
            const float bmid = t0 + t1, blast = (t0 + t1) + (t2 + t3);
            if (seg == 0) DEC[d] = __expf(blast);
#pragma unroll
            for (int r = 0; r < 16; ++r) {
                const int row = seg * 16 + r;
                const float bb = off + bl[r];
                const float k = -expm1f(lf[r]);
                Qt[row * 136 + d] = f2bf(qs[r] * __expf(bb - bmid));
                Kt[row * 136 + d] = f2bf(k * __expf(bmid - bb));
                Qh[row * 136 + d] = f2bf(qs[r] * __expf(bb));
                KhT[d * 72 + row] = f2bf(k * __expf(blast - bb));
            }
        }
        __syncthreads();
        {
            const int tt = wave >> 1, st0 = 2 * (wave & 1);
            f32x4 a2[2]; a2[0] = (f32x4){0.f, 0.f, 0.f, 0.f}; a2[1] = (f32x4){0.f, 0.f, 0.f, 0.f};
#pragma unroll
            for (int kb = 0; kb < 4; ++kb) {
                const bf16x8 a = *(const LAS bf16x8*)(Qt + (16 * tt + r16) * 136 + 32 * kb + 8 * quad);
#pragma unroll
                for (int j = 0; j < 2; ++j) { const bf16x8 bq = *(const LAS bf16x8*)(Kt + (16 * (st0 + j) + r16) * 136 + 32 * kb + 8 * quad); a2[j] = MFMA16(a, bq, a2[j]); }
            }
#pragma unroll
            for (int j = 0; j < 2; ++j)
#pragma unroll
                for (int e = 0; e < 4; ++e) { const int t = 16 * tt + 4 * quad + e, s = 16 * (st0 + j) + r16; As[t * 72 + s] = f2bf(s <= t ? a2[j][e] : 0.f); }
        }
        __syncthreads();
        {
            const int tt = wave & 3, vt0 = 4 * (wave >> 2);
            f32x4 o4[4];
#pragma unroll
            for (int j = 0; j < 4; ++j) o4[j] = (f32x4){0.f, 0.f, 0.f, 0.f};
#pragma unroll
            for (int kb = 0; kb < 2; ++kb) {
                const bf16x8 a = *(const LAS bf16x8*)(As + (16 * tt + r16) * 72 + 32 * kb + 8 * quad);
#pragma unroll
                for (int j = 0; j < 4; ++j) { const bf16x8 bv = *(const LAS bf16x8*)(VT + (16 * (vt0 + j) + r16) * 72 + 32 * kb + 8 * quad); o4[j] = MFMA16(a, bv, o4[j]); }
            }
#pragma unroll
            for (int kb = 0; kb < 4; ++kb) {
                const bf16x8 a = *(const LAS bf16x8*)(Qh + (16 * tt + r16) * 136 + 32 * kb + 8 * quad);
#pragma unroll
                for (int j = 0; j < 4; ++j) { const bf16x8 bs = *(const LAS bf16x8*)(ST + (16 * (vt0 + j) + r16) * 136 + 32 * kb + 8 * quad); o4[j] = MFMA16(a, bs, o4[j]); }
            }
#pragma unroll
            for (int j = 0; j < 4; ++j)
#pragma unroll
                for (int e = 0; e < 4; ++e) Ob[(16 * tt + 4 * quad + e) * 132 + 16 * (vt0 + j) + r16] = o4[j][e];
        }
        {
            const f32x4 dec = *(const LAS f32x4*)(DEC + 16 * wave + 4 * quad);
#pragma unroll
            for (int vt = 0; vt < 8; ++vt) S[vt] = S[vt] * dec;
#pragma unroll
            for (int kb = 0; kb < 2; ++kb) {
                const bf16x8 a = *(const LAS bf16x8*)(KhT + (16 * wave + r16) * 72 + 32 * kb + 8 * quad);
#pragma unroll
                for (int vt = 0; vt < 8; ++vt) { const bf16x8 bv = *(const LAS bf16x8*)(VT + (16 * vt + r16) * 72 + 32 * kb + 8 * quad); S[vt] = MFMA16(a, bv, S[vt]); }
            }
        }
        __syncthreads();
#pragma unroll
        for (int vt = 0; vt < 8; ++vt) { u32x2 w; w.x = pk2(S[vt][0], S[vt][1]); w.y = pk2(S[vt][2], S[vt][3]); *(LAS u32x2*)(ST + (16 * vt + r16) * 136 + 16 * wave + 4 * quad) = w; }
        {
            const int row = tid >> 3, sub = tid & 7;
            float ov[16], ss = 0.f;
#pragma unroll
            for (int k = 0; k < 16; ++k) { ov[k] = Ob[row * 132 + 16 * sub + k]; ss += ov[k] * ov[k]; }
            ss += __shfl_xor(ss, 1); ss += __shfl_xor(ss, 2); ss += __shfl_xor(ss, 4);
            const float rstd = 1.f / sqrtf(ss * (1.f / 128.f) + RMS_EPS);
            const bf16_t* gp = PROJ + (size_t)(m0 + row) * NPROJ + C_HG + h * 128 + 16 * sub;
            const u32x4 g0 = *(const u32x4*)gp, g1 = *(const u32x4*)(gp + 8);
            const unsigned gw[8] = {g0.x, g0.y, g0.z, g0.w, g1.x, g1.y, g1.z, g1.w};
            unsigned w[8];
#pragma unroll
            for (int k = 0; k < 8; ++k) {
                const float ga = __uint_as_float(gw[k] << 16), gb = __uint_as_float(gw[k] & 0xffff0000u);
                const float ra = ov[2 * k] * rstd * gnorm[16 * sub + 2 * k] * (ga / (1.f + __expf(-ga)));
                const float rb = ov[2 * k + 1] * rstd * gnorm[16 * sub + 2 * k + 1] * (gb / (1.f + __expf(-gb)));
                w[k] = pk2(ra, rb);
            }
            bf16_t* dst = MIX + (size_t)(m0 + row) * DM + h * 128 + 16 * sub;
            *(u32x4*)dst = (u32x4){w[0], w[1], w[2], w[3]}; *(u32x4*)(dst + 8) = (u32x4){w[4], w[5], w[6], w[7]};
        }
        __syncthreads();
    }
}

__device__ __forceinline__ void hgrn_item_naive(const Params& p, int l, int item, LAS unsigned char* lds, int tid, int wave, int lane) {
    const int b = item >> 2, h = item & 3;
    unsigned char* ws = p.ws;
    const bf16_t* PROJ = (const bf16_t*)(ws + WS_PROJ);
    const float* LOGF = (const float*)(ws + WS_LOGF);
    bf16_t* MIX = (bf16_t*)(ws + WS_MIX);
    const float* gnorm = p.in[4] + l * 128;
    LAS float* Ob = (LAS float*)lds;
    LAS float* Fq = (LAS float*)(lds + 33792);
    LAS float* Ff = (LAS float*)(lds + 66560);
    LAS float* Pp = (LAS float*)(lds + 99328);
    const int v = tid & 127, dg = tid >> 7;
    float S[32];
#pragma unroll
    for (int i = 0; i < 32; ++i) S[i] = 0.f;
    for (int c = 0; c < 32; ++c) {
        const int m0 = b * T + c * 64;
        float vv[16];
        {
            const int d = tid & 127, seg = tid >> 7;
#pragma unroll
            for (int r = 0; r < 16; ++r) {
                const int row = seg * 16 + r;
                const bf16_t* pr = PROJ + (size_t)(m0 + row) * NPROJ + h * 128 + d;
                const float lf = LOGF[(size_t)(m0 + row) * 512 + h * 128 + d];
                const float q = bf2f(pr[C_HQ]);
                Fq[row * 128 + d] = q / (1.f + expf(-q));
                Ff[row * 128 + d] = expf(lf);
            }
        }
        __syncthreads();
        for (int t = 0; t < 64; ++t) {
            const float vt = bf2f(PROJ[(size_t)(m0 + t) * NPROJ + C_HI + h * 128 + v]);
            float part = 0.f;
#pragma unroll
            for (int i4 = 0; i4 < 8; ++i4) {
                const f32x4 f4 = *(const LAS f32x4*)(Ff + t * 128 + dg * 32 + 4 * i4);
                const f32x4 q4 = *(const LAS f32x4*)(Fq + t * 128 + dg * 32 + 4 * i4);
#pragma unroll
                for (int e = 0; e < 4; ++e) { const int i = 4 * i4 + e; S[i] = f4[e] * S[i] + (1.f - f4[e]) * vt; part += q4[e] * S[i]; }
            }
            Pp[(t & 1) * 512 + dg * 128 + v] = part;
            __syncthreads();
            if (dg == 0) Ob[t * 132 + v] = (Pp[(t & 1) * 512 + v] + Pp[(t & 1) * 512 + 128 + v]) + (Pp[(t & 1) * 512 + 256 + v] + Pp[(t & 1) * 512 + 384 + v]);
        }
        __syncthreads();
        {
            const int row = tid >> 3, sub = tid & 7;
            float ov[16], ss = 0.f;
#pragma unroll
            for (int k = 0; k < 16; ++k) { ov[k] = Ob[row * 132 + 16 * sub + k]; ss += ov[k] * ov[k]; }
            ss += __shfl_xor(ss, 1); ss += __shfl_xor(ss, 2); ss += __shfl_xor(ss, 4);
            const float rstd = 1.f / sqrtf(ss * (1.f / 128.f) + RMS_EPS);
            const bf16_t* gp = PROJ + (size_t)(m0 + row) * NPROJ + C_HG + h * 128 + 16 * sub;
            bf16_t* dst = MIX + (size_t)(m0 + row) * DM + h * 128 + 16 * sub;
#pragma unroll
            for (int k = 0; k < 16; ++k) { const float ga = bf2f(gp[k]); dst[k] = f2bf(ov[k] * rstd * gnorm[16 * sub + k] * (ga / (1.f + expf(-ga)))); }
        }
        __syncthreads();
    }
}

template <bool DUAL, class F>
__device__ __forceinline__ void naive_gemm(const bf16_t* A, int K, const float* W, int ldw, int ncols, int dual_off, LAS unsigned char* lds, int bid, int G, int tid, const F& store) {
    LAS float* As = (LAS float*)lds;
    LAS float* Bs = (LAS float*)(lds + 8448);
    LAS float* Bs2 = (LAS float*)(lds + 8448 + 16384);
    const int nct = (ncols + 127) / 128, ntiles = (M / 64) * nct;
    const int tr = tid >> 5, tc = tid & 31;
    for (int tile = bid; tile < ntiles; tile += G) {
        const int rt = tile / nct, ct = tile % nct, r0 = rt * 64, c0 = ct * 128;
        float acc[4][4], acc2[4][4];
#pragma unroll
        for (int i = 0; i < 4; ++i)
#pragma unroll
            for (int j = 0; j < 4; ++j) { acc[i][j] = 0.f; acc2[i][j] = 0.f; }
        for (int k0 = 0; k0 < K; k0 += 32) {
            __syncthreads();
#pragma unroll
            for (int q = 0; q < 4; ++q) { const int e = tid + 512 * q, r = e >> 5, kk = e & 31; As[r * 33 + kk] = bf2f(A[(size_t)(r0 + r) * K + k0 + kk]); }
#pragma unroll
            for (int q = 0; q < 8; ++q) { const int e = tid + 512 * q, kk = e >> 7, c = e & 127; const int col = c0 + c;
                Bs[kk * 128 + c] = (col < ncols) ? W[(size_t)(k0 + kk) * ldw + col] : 0.f;
                if (DUAL) Bs2[kk * 128 + c] = (col < ncols) ? W[(size_t)(k0 + kk) * ldw + dual_off + col] : 0.f; }
            __syncthreads();
            for (int kk = 0; kk < 32; ++kk) {
                float a[4], b[4], b2[4];
#pragma unroll
                for (int i = 0; i < 4; ++i) a[i] = As[(4 * tr + i) * 33 + kk];
#pragma unroll
                for (int j = 0; j < 4; ++j) { b[j] = Bs[kk * 128 + tc + 32 * j]; b2[j] = DUAL ? Bs2[kk * 128 + tc + 32 * j] : 0.f; }
#pragma unroll
                for (int i = 0; i < 4; ++i)
#pragma unroll
                    for (int j = 0; j < 4; ++j) { acc[i][j] += a[i] * b[j]; if (DUAL) acc2[i][j] += a[i] * b2[j]; }
            }
        }
#pragma unroll
        for (int i = 0; i < 4; ++i)
#pragma unroll
            for (int j = 0; j < 4; ++j) { const int col = c0 + tc + 32 * j; if (col < ncols) store(r0 + 4 * tr + i, col, acc[i][j], acc2[i][j]); }
    }
    __syncthreads();
}
struct StProj { bf16_t* P; float* LOGF; const float* lb;
    __device__ __forceinline__ void operator()(int row, int col, float v, float) const {
        if (col >= C_HF && col < C_HI) { const float l = lb[col - C_HF]; const float s = 1.f / (1.f + expf(-v)); LOGF[(size_t)row * 512 + col - C_HF] = logf(l + (1.f - l) * s); }
        else P[(size_t)row * NPROJ + col] = f2bf(v); } };
struct StRes { const float* base; float* out;
    __device__ __forceinline__ void operator()(int row, int col, float v, float) const { out[(size_t)row * DM + col] = base[(size_t)row * DM + col] + v; } };
struct StSwi { bf16_t* A;
    __device__ __forceinline__ void operator()(int row, int col, float g, float u) const { A[(size_t)row * DFF + col] = f2bf(g / (1.f + expf(-g)) * u); } };

template <int MODE>
__device__ __forceinline__ void attn_tile(const LAS bf16_t* Ks, const LAS bf16_t* Vs, const bf16x8 (&qf)[2][2], f32x4 (&o)[2][4], float (&lsum)[2], float m0,
                                          const int (&tk)[2], const unsigned (&selm)[2], int j, int quad, int r16, int mask_kind) {
    f32x4 s[2][4];
    const float nm0 = -m0;
#pragma unroll
    for (int kt = 0; kt < 4; ++kt) {
        s[0][kt] = (f32x4){nm0, nm0, nm0, nm0}; s[1][kt] = (f32x4){nm0, nm0, nm0, nm0};
#pragma unroll
        for (int kb = 0; kb < 2; ++kb) {
            const bf16x8 a = *(const LAS bf16x8*)(Ks + (16 * kt + r16) * 72 + 32 * kb + 8 * quad);
            s[0][kt] = MFMA16(a, qf[0][kb], s[0][kt]); s[1][kt] = MFMA16(a, qf[1][kb], s[1][kt]);
        }
    }
    bf16x8 pf[2][2];
#pragma unroll
    for (int rt = 0; rt < 2; ++rt) {
#pragma unroll
        for (int kt = 0; kt < 4; ++kt)
#pragma unroll
            for (int e = 0; e < 4; ++e) s[rt][kt][e] = __builtin_amdgcn_exp2f(s[rt][kt][e]);
        const bool blk = (MODE == 1) ? (((selm[rt] >> j) & 1u) != 0u) : true;
        if (mask_kind == 2) {
            const int kbase = 64 * j + 4 * quad;
            const int hi = blk ? tk[rt] : -1;
            const int lo = (MODE == 2) ? tk[rt] - 512 : -1;
#pragma unroll
            for (int kt = 0; kt < 4; ++kt)
#pragma unroll
                for (int e = 0; e < 4; ++e) {
                    const int kpos = kbase + 16 * kt + e;
                    const bool v = (kpos <= hi) && (kpos > lo);
                    s[rt][kt][e] = v ? s[rt][kt][e] : 0.f;
                }
        }
        float rs = 0.f;
#pragma unroll
        for (int kt = 0; kt < 4; ++kt) rs += (s[rt][kt][0] + s[rt][kt][1]) + (s[rt][kt][2] + s[rt][kt][3]);
        const unsigned keep = (mask_kind == 1 && !blk) ? 0u : 0xffffffffu;
        if (mask_kind == 1) rs = blk ? rs : 0.f;
        lsum[rt] += rs;
#pragma unroll
        for (int kb2 = 0; kb2 < 2; ++kb2) {
            u32x4 w;
            w.x = pk2(s[rt][2 * kb2][0], s[rt][2 * kb2][1]); w.y = pk2(s[rt][2 * kb2][2], s[rt][2 * kb2][3]);
            w.z = pk2(s[rt][2 * kb2 + 1][0], s[rt][2 * kb2 + 1][1]); w.w = pk2(s[rt][2 * kb2 + 1][2], s[rt][2 * kb2 + 1][3]);
            if (mask_kind == 1) { w.x &= keep; w.y &= keep; w.z &= keep; w.w &= keep; }
            pf[rt][kb2] = __builtin_bit_cast(bf16x8, w);
        }
    }
#pragma unroll
    for (int dt = 0; dt < 4; ++dt)
#pragma unroll
        for (int kb2 = 0; kb2 < 2; ++kb2) {
            const u32x2 v0 = *(const LAS u32x2*)(Vs + (16 * dt + r16) * 136 + 32 * kb2 + 4 * quad);
            const u32x2 v1 = *(const LAS u32x2*)(Vs + (16 * dt + r16) * 136 + 32 * kb2 + 16 + 4 * quad);
            const bf16x8 vf = __builtin_bit_cast(bf16x8, ((u32x4){v0.x, v0.y, v1.x, v1.y}));
            o[0][dt] = MFMA16(vf, pf[0][kb2], o[0][dt]); o[1][dt] = MFMA16(vf, pf[1][kb2], o[1][dt]);
        }
}

template <int MODE>
__device__ __forceinline__ void attn_branch(const bf16_t* Kb, const bf16_t* VTb, LAS bf16_t* Ks, LAS bf16_t* Vs, const bf16x8 (&qf)[2][2], LAS f32x4* outs,
                                            const float (&gsc)[2], const int (&tk)[2], const unsigned (&selm)[2], unsigned uni, bool sel_varies, int jlo, int jhi, int tid, int quad, int r16, float m0) {
    f32x4 o[2][4];
#pragma unroll
    for (int rt = 0; rt < 2; ++rt)
#pragma unroll
        for (int dt = 0; dt < 4; ++dt) o[rt][dt] = (f32x4){0.f, 0.f, 0.f, 0.f};
    float lsum[2] = {0.f, 0.f};
    const int lr = tid >> 3, lc = (tid & 7) * 8;
#define NSA_NEXT(jv) do { ++(jv); } while ((jv) <= jhi && !((uni >> (jv)) & 1u))
#define NSA_LOAD(kr, vr, jv) do { kr = *(const u32x4*)(Kb + (size_t)(64 * (jv) + lr) * 64 + lc); vr = *(const u32x4*)(VTb + (size_t)(64 * (jv) + lr) * 64 + lc); } while (0)
#define NSA_STEP(kr, vr, jcur, jload) do { LDS_BARRIER(); *(LAS u32x4*)(Ks + lr * 72 + lc) = kr; *(LAS u32x4*)(Vs + lr * 136 + lc) = vr; \
        if ((jload) <= jhi) NSA_LOAD(kr, vr, jload); LDS_BARRIER(); \
        attn_tile<MODE>(Ks, Vs, qf, o, lsum, m0, tk, selm, jcur, quad, r16, (((jcur) == jhi) || (MODE == 2 && (jcur) + 8 <= jhi)) ? 2 : ((MODE == 1 && sel_varies) ? 1 : 0)); } while (0)
    int j0 = jlo - 1; NSA_NEXT(j0);
    int j1 = j0; NSA_NEXT(j1);
    u32x4 kA = (u32x4){0u, 0u, 0u, 0u}, vA = kA, kB = kA, vB = kA;
    if (j0 <= jhi) NSA_LOAD(kA, vA, j0);
    if (j1 <= jhi) NSA_LOAD(kB, vB, j1);
    while (j0 <= jhi) {
        int j2 = j1; NSA_NEXT(j2);
        NSA_STEP(kA, vA, j0, j2);
        if (j1 > jhi) break;
        int j3 = j2; NSA_NEXT(j3);
        NSA_STEP(kB, vB, j1, j3);
        j0 = j2; j1 = j3;
    }
#undef NSA_NEXT
#undef NSA_LOAD
#undef NSA_STEP
#pragma unroll
    for (int rt = 0; rt < 2; ++rt) {
        float lr_ = lsum[rt]; lr_ += __shfl_xor(lr_, 16); lr_ += __shfl_xor(lr_, 32);
        const float inv = lr_ > 0.f ? gsc[rt] / lr_ : 0.f;
#pragma unroll
        for (int dt = 0; dt < 4; ++dt) outs[(rt * 4 + dt) * 64] = outs[(rt * 4 + dt) * 64] + o[rt][dt] * inv;
    }
}

__device__ __forceinline__ void nsa_unit(const Params& p, int l, int item, LAS unsigned char* lds, int tid, int wave, int lane) {
    const int qt = 31 - (item & 31), bg = item >> 5, b = bg >> 1, g = bg & 1, t0 = qt * 64;
    const int quad = lane >> 4, r16 = lane & 15, hh = lane & 3;
    unsigned char* ws = p.ws;
    const bf16_t* PROJ = (const bf16_t*)(ws + WS_PROJ);
    LAS bf16_t* Ks = (LAS bf16_t*)lds;
    LAS bf16_t* Vs = (LAS bf16_t*)(lds + 18432);
    LAS float* IMP = (LAS float*)(lds + 35840);
    LAS unsigned* SEL = (LAS unsigned*)(lds + 44288);
    int tk[2]; tk[0] = t0 + 8 * wave + (r16 >> 2); tk[1] = tk[0] + 4;
    bf16x8 qf[2][2];
    {
        const bf16_t* Qb = (const bf16_t*)(ws + WS_QN) + ((size_t)bg * T + t0) * 256;
#pragma unroll
        for (int rt = 0; rt < 2; ++rt)
#pragma unroll
            for (int kb = 0; kb < 2; ++kb) qf[rt][kb] = *(const bf16x8*)(Qb + (size_t)(32 * wave + 16 * rt + r16) * 64 + 32 * kb + 8 * quad);
    }
    float gt[3][2];
#pragma unroll
    for (int rt = 0; rt < 2; ++rt)
#pragma unroll
        for (int br = 0; br < 3; ++br) { const float z = bf2f(PROJ[(size_t)(b * T + tk[rt]) * NPROJ + C_GT + (g * 4 + hh) * 3 + br]); gt[br][rt] = 1.f / (1.f + __expf(-z)); }
    float m0c, m0s, m0w;
    {
        const float* qg = p.in[5] + l * 64; const float* kg = p.in[6] + l * 192;
        float gq = fabsf(qg[lane]), g0 = fabsf(kg[lane]), g1 = fabsf(kg[64 + lane]), g2 = fabsf(kg[128 + lane]);
#pragma unroll
        for (int ofs = 1; ofs < 64; ofs <<= 1) { gq = fmaxf(gq, __shfl_xor(gq, ofs)); g0 = fmaxf(g0, __shfl_xor(g0, ofs)); g1 = fmaxf(g1, __shfl_xor(g1, ofs)); g2 = fmaxf(g2, __shfl_xor(g2, ofs)); }
        m0c = 64.f * QSCALE * gq * g0 * 1.001f; m0s = 64.f * QSCALE * gq * g1 * 1.001f; m0w = 64.f * QSCALE * gq * g2 * 1.001f;
    }
    f32x4 out[2][4];
#pragma unroll
    for (int rt = 0; rt < 2; ++rt)
#pragma unroll
        for (int dt = 0; dt < 4; ++dt) out[rt][dt] = (f32x4){0.f, 0.f, 0.f, 0.f};
    {
        const bf16_t* KCb = (const bf16_t*)(ws + WS_KC) + (size_t)bg * 128 * 64;
        const bf16_t* VCb = (const bf16_t*)(ws + WS_VCT) + (size_t)bg * 64 * 128;
#pragma unroll
        for (int k = 0; k < 2; ++k) {
            const int c = tid + 512 * k;
            *(LAS u32x4*)(Ks + (c >> 3) * 72 + (c & 7) * 8) = *(const u32x4*)(KCb + (size_t)(c >> 3) * 64 + (c & 7) * 8);
            *(LAS u32x4*)(Vs + (c >> 4) * 136 + (c & 15) * 8) = *(const u32x4*)(VCb + (size_t)(c >> 4) * 128 + (c & 15) * 8);
        }
        __syncthreads();
#pragma unroll
        for (int rt = 0; rt < 2; ++rt) {
            f32x4 s[8];
#pragma unroll
            for (int kt = 0; kt < 8; ++kt) {
                s[kt] = (f32x4){0.f, 0.f, 0.f, 0.f};
#pragma unroll
                for (int kb = 0; kb < 2; ++kb) { const bf16x8 a = *(const LAS bf16x8*)(Ks + (16 * kt + r16) * 72 + 32 * kb + 8 * quad); s[kt] = MFMA16(a, qf[rt][kb], s[kt]); }
            }
            float rs = 0.f;
#pragma unroll
            for (int kt = 0; kt < 8; ++kt)
#pragma unroll
                for (int e = 0; e < 4; ++e) { const int n = 16 * kt + 4 * quad + e; const bool v = (16 * n + 31 <= tk[rt]); const float pv = v ? __builtin_amdgcn_exp2f(s[kt][e] - m0c) : 0.f; s[kt][e] = pv; rs += pv; }
            rs += __shfl_xor(rs, 16); rs += __shfl_xor(rs, 32);
            const float inv = rs > 0.f ? 1.f / rs : 0.f;
#pragma unroll
            for (int kt = 0; kt < 8; ++kt) s[kt] = s[kt] * inv;
            if (qt >= 16) {
                float sh[8];
#pragma unroll
                for (int kt = 0; kt < 8; ++kt) sh[kt] = __shfl(s[kt][3], (lane + 48) & 63);
#pragma unroll
                for (int kt = 0; kt < 8; ++kt) {
                    const float nb = quad ? sh[kt] : (kt ? sh[kt > 0 ? kt - 1 : 0] : 0.f);
                    float im = (s[kt][0] + s[kt][1]) + (s[kt][2] + s[kt][3]) + nb;
                    im += __shfl_xor(im, 1); im += __shfl_xor(im, 2);
                    if (hh == 0) IMP[(8 * wave + 4 * rt + (r16 >> 2)) * 33 + 4 * kt + quad] = im;
                }
            }
            const float gs = gt[0][rt];
#pragma unroll
            for (int dt = 0; dt < 4; ++dt) {
                f32x4 oc = (f32x4){0.f, 0.f, 0.f, 0.f};
#pragma unroll
                for (int kb2 = 0; kb2 < 4; ++kb2) {
                    u32x4 w;
                    w.x = pk2(s[2 * kb2][0], s[2 * kb2][1]); w.y = pk2(s[2 * kb2][2], s[2 * kb2][3]);
                    w.z = pk2(s[2 * kb2 + 1][0], s[2 * kb2 + 1][1]); w.w = pk2(s[2 * kb2 + 1][2], s[2 * kb2 + 1][3]);
                    const bf16x8 pfr = __builtin_bit_cast(bf16x8, w);
                    const u32x2 v0 = *(const LAS u32x2*)(Vs + (16 * dt + r16) * 136 + 32 * kb2 + 4 * quad);
                    const u32x2 v1 = *(const LAS u32x2*)(Vs + (16 * dt + r16) * 136 + 32 * kb2 + 16 + 4 * quad);
                    const bf16x8 vf = __builtin_bit_cast(bf16x8, ((u32x4){v0.x, v0.y, v1.x, v1.y}));
                    oc = MFMA16(vf, pfr, oc);
                }
                out[rt][dt] = out[rt][dt] + oc * gs;
            }
            asm volatile("" ::: "memory");
        }
    }
    LAS f32x4* outs = (LAS f32x4*)(lds + 49152) + wave * 512 + lane;
#pragma unroll
    for (int rt = 0; rt < 2; ++rt)
#pragma unroll
        for (int dt = 0; dt < 4; ++dt) outs[(rt * 4 + dt) * 64] = out[rt][dt];
    unsigned selm[2], uni;
    if (qt >= 16) {
        __syncthreads();
#pragma unroll
        for (int ps = 0; ps < 4; ++ps) {
            const int token = 16 * ps + (tid >> 5), j = tid & 31;
            const float my = IMP[token * 33 + j];
            int rank = 0;
            for (int jj = 1; jj <= qt - 2; ++jj) { const float ov = IMP[token * 33 + jj]; rank += ((ov > my) || (ov == my && jj < j)) ? 1 : 0; }
            const bool sel = (j == 0) || (j == qt) || (j == qt - 1) || (j >= 1 && j <= qt - 2 && rank < 13);
            const unsigned long long bal = __ballot(sel);
            if ((lane & 31) == 0) SEL[token] = (lane < 32) ? (unsigned)bal : (unsigned)(bal >> 32);
        }
        __syncthreads();
        selm[0] = SEL[8 * wave + (r16 >> 2)]; selm[1] = SEL[8 * wave + 4 + (r16 >> 2)];
        uni = 0u;
        for (int k = 0; k < 64; ++k) uni |= SEL[k];
        uni = __builtin_amdgcn_readfirstlane(uni);
    } else { selm[0] = selm[1] = uni = (2u << qt) - 1u; }
    {
        const float gsc[2] = {gt[1][0], gt[1][1]};
        attn_branch<1>((const bf16_t*)(ws + WS_KS) + (size_t)bg * T * 64, (const bf16_t*)(ws + WS_VST) + (size_t)bg * 64 * T, Ks, Vs, qf, outs, gsc, tk, selm, uni, qt >= 16, 0, qt, tid, quad, r16, m0s);
    }
    {
        const float gsc[2] = {gt[2][0], gt[2][1]};
        attn_branch<2>((const bf16_t*)(ws + WS_KW) + (size_t)bg * T * 64, (const bf16_t*)(ws + WS_VWT) + (size_t)bg * 64 * T, Ks, Vs, qf, outs, gsc, tk, selm, 0xffffffffu, false, qt > 8 ? qt - 8 : 0, qt, tid, quad, r16, m0w);
    }
    {
        bf16_t* MIX = (bf16_t*)(ws + WS_MIX);
#pragma unroll
        for (int rt = 0; rt < 2; ++rt)
#pragma unroll
            for (int dt = 0; dt < 4; ++dt) {
                const f32x4 ov = outs[(rt * 4 + dt) * 64];
                u32x2 w; w.x = pk2(ov[0], ov[1]); w.y = pk2(ov[2], ov[3]);
                if (NSA_ZERO) { w.x = 0u; w.y = 0u; }
                *(u32x2*)(MIX + (size_t)(b * T + tk[rt]) * DM + 512 + (g * 4 + hh) * 64 + 16 * dt + 4 * quad) = w;
            }
    }
    __syncthreads();
}

#ifndef PROBE_NSA2
#define PROBE_NSA2 0
#endif
#ifndef PROBE_HG2
#define PROBE_HG2 0
#endif
#ifndef PROBE_DUP
#define PROBE_DUP 0
#endif
#ifndef NAIVE_MASK
#define NAIVE_MASK 0
#endif
#ifndef HG_NAIVE
#define HG_NAIVE 0
#endif
#ifndef PHMASK
#define PHMASK 0x1ff
#endif
constexpr int N_PHASES = 1 + 8 * DEPTH;
__global__ void __launch_bounds__(NTHREADS) fwd_kernel(Params p) {
    extern __shared__ __attribute__((aligned(16))) unsigned char lds_raw[];
    LAS unsigned char* lds = (LAS unsigned char*)lds_raw;
    const int G = gridDim.x, NGW = G * 8;
    unsigned char* ws = p.ws;
    for (int ph = p.ph_lo; ph < p.ph_hi; ++ph) {
        if (ph > p.ph_lo) {
            asm volatile("s_waitcnt vmcnt(0)" ::: "memory");
            __syncthreads();
            cg::this_grid().sync();
            __builtin_amdgcn_fence(__ATOMIC_ACQUIRE, "agent");
            asm volatile("s_waitcnt vmcnt(0)" ::: "memory");
            __syncthreads();
        }
        const int code = p.prog[ph], l = code >> 4, sub = code & 15;
        int tid = threadIdx.x; asm volatile("" : "+v"(tid));
        int bid = blockIdx.x; asm volatile("" : "+s"(bid));
        const int lane = tid & 63, wave = __builtin_amdgcn_readfirstlane(tid >> 6), gw = bid * 8 + wave;
        if (sub == 8) { prologue_phase(p, lds, gw, NGW, wave, lane); continue; }
        if (sub == 0 && (PHMASK & 2)) {
            pg8::Gemm g{(const bf16_t*)(ws + WS_XN), (const bf16_t*)(ws + WS_WIN) + (size_t)l * NPROJ * DM, M, NPROJ, DM};
            pg8::StaticOrder S; S.init(M, NPROJ, G, bid);
            EpiProj E{(bf16_t*)(ws + WS_PROJ), (float*)(ws + WS_LOGF), (const float*)(ws + WS_CTL + 16384) + l * 512};
            if (NAIVE_MASK & 1) { StProj st{(bf16_t*)(ws + WS_PROJ), (float*)(ws + WS_LOGF), (const float*)(ws + WS_CTL + 16384) + l * 512};
                naive_gemm<false>((const bf16_t*)(ws + WS_XN), DM, p.in[1] + (size_t)l * DM * INW, INW, INW, 0, lds, bid, G, tid, st); }
            else pg8::gemm_phase<EpiProj, pg8::StaticOrder, true, true>(lds, g, S, E, tid);
        } else if (sub == 1 && (PHMASK & 4)) {
            for (int it = bid; it < 256 + 1024; it += G) {
                int t2 = tid; asm volatile("" : "+v"(t2));
                const int l2 = t2 & 63, w2 = __builtin_amdgcn_readfirstlane(t2 >> 6);
                if (it < 256) compress_item(p, l, it, lds, t2, w2, l2);
                else prep_item(p, l, it - 256, lds, t2, w2, l2);
            }
        } else if ((sub == 2 || sub == 9) && (PHMASK & 8)) {
            unsigned* ctr = (unsigned*)(ws + WS_CTL) + 64 * ph;
            LAS int* qslot = (LAS int*)(lds + LDS_BYTES - 16);
            for (;;) {
                if (tid == 0) *qslot = (int)atomicAdd(ctr, 1u) + (sub == 9 ? 128 : 0);
                __syncthreads();
                const int item = *qslot;
                __syncthreads();
                if (item >= 128 + 2048) break;
                int t2 = tid; asm volatile("" : "+v"(t2));
                const int l2 = t2 & 63, w2 = __builtin_amdgcn_readfirstlane(t2 >> 6);
                if (item < 128) { if (HG_NAIVE) hgrn_item_naive(p, l, item, lds, t2, w2, l2); else hgrn_item(p, l, item, lds, t2, w2, l2);
                    if (PROBE_HG2) { int t3 = t2; asm volatile("" : "+v"(t3)); hgrn_item(p, l, item, lds, t3, __builtin_amdgcn_readfirstlane(t3 >> 6), t3 & 63); } }
                else { nsa_unit(p, l, item - 128, lds, t2, w2, l2);
                }
            }
        } else if ((sub == 3 || sub == 6) && (PHMASK & 16)) {
            const bool ffn = (sub == 6);
            pg8::Gemm g{ffn ? (const bf16_t*)(ws + WS_PROJ) : (const bf16_t*)(ws + WS_MIX),
                        ffn ? (const bf16_t*)(ws + WS_WFFO) + (size_t)l * DM * DFF : (const bf16_t*)(ws + WS_WOUT) + (size_t)l * DM * DM, M, DM, ffn ? DFF : DM};
            pg8::StaticOrder S; S.init(M, DM, G, bid);
            EpiRes E{(l == 0 && !ffn) ? p.in[0] : (const float*)p.out, p.out};
            if (!ffn && (NAIVE_MASK & 2)) { StRes st{(l == 0) ? p.in[0] : (const float*)p.out, p.out};
                naive_gemm<false>((const bf16_t*)(ws + WS_MIX), DM, p.in[2] + (size_t)l * DM * DM, DM, DM, 0, lds, bid, G, tid, st); }
            else if (ffn && (NAIVE_MASK & 8)) { StRes st{(const float*)p.out, p.out};
                naive_gemm<false>((const bf16_t*)(ws + WS_PROJ), DFF, p.in[14] + (size_t)l * DFF * DM, DM, DM, 0, lds, bid, G, tid, st); }
            else pg8::gemm_phase<EpiRes, pg8::StaticOrder, true, true>(lds, g, S, E, tid);
        } else if (sub == 4 && (PHMASK & 32)) {
            norm_phase(p.out, p.in[16] + l * DM, (bf16_t*)(ws + WS_XN), gw, NGW, lane);
        } else if (sub == 5 && (PHMASK & 64)) {
            pg8::Gemm g{(const bf16_t*)(ws + WS_XN), (const bf16_t*)(ws + WS_WFFI) + (size_t)l * 2 * DFF * DM, M, 2 * DFF, DM};
            pg8::StaticOrder S; S.init(M, 2 * DFF, G, bid);
            EpiSwiGLU E{(bf16_t*)(ws + WS_PROJ)};
            if (NAIVE_MASK & 4) { StSwi st{(bf16_t*)(ws + WS_PROJ)};
                naive_gemm<true>((const bf16_t*)(ws + WS_XN), DM, p.in[13] + (size_t)l * DM * 2 * DFF, 2 * DFF, DFF, DFF, lds, bid, G, tid, st); }
            else pg8::gemm_phase<EpiSwiGLU, pg8::StaticOrder, true, true>(lds, g, S, E, tid);
        } else if (sub == 7) {
            if (l + 1 < DEPTH) norm_phase(p.out, p.in[15] + (l + 1) * DM, (bf16_t*)(ws + WS_XN), gw, NGW, lane);
        }
    }
}

#ifndef MK_COOP
#define MK_COOP 1
#endif
extern "C" void kernel_launch(void* const* d_in, const int* in_sizes, int n_in, void* d_out, int out_size, void* d_ws, size_t ws_size, hipStream_t stream) {
    static int grid = 0;
    if (grid == 0) {
        if (n_in != 17 || out_size != M * DM || ws_size < WS_END) { fprintf(stderr, "kernel_launch: unexpected shapes (n_in %d out %d ws %zu)\n", n_in, out_size, ws_size); grid = -1; return; }
        int dev = 0, cus = 0, per_cu = 0;
        (void)hipGetDevice(&dev); (void)hipDeviceGetAttribute(&cus, hipDeviceAttributeMultiprocessorCount, dev);
        if (hipFuncSetAttribute((const void*)fwd_kernel, hipFuncAttributeMaxDynamicSharedMemorySize, LDS_BYTES) != hipSuccess) { fprintf(stderr, "kernel_launch: hipFuncSetAttribute failed\n"); grid = -1; return; }
        if (hipOccupancyMaxActiveBlocksPerMultiprocessor(&per_cu, (const void*)fwd_kernel, NTHREADS, LDS_BYTES) != hipSuccess || per_cu < 1) { fprintf(stderr, "kernel_launch: occupancy query says %d\n", per_cu); per_cu = 1; }
        (void)hipGetLastError();
        grid = cus > 0 ? cus : 256;
    }
    if (grid < 0) return;
    Params p{};
    for (int i = 0; i < 17; ++i) p.in[i] = (const float*)d_in[i];
    p.out = (float*)d_out; p.ws = (unsigned char*)d_ws;
    int np = 0;
    auto add = [&](int l, int sub, int dupbit) { p.prog[np++] = (unsigned char)((l << 4) | sub); if (PROBE_DUP & dupbit) p.prog[np++] = (unsigned char)((l << 4) | sub); };
    add(0, 8, 1);
    for (int l = 0; l < DEPTH; ++l) { add(l, 0, 0); add(l, 1, 2); add(l, 2, 4); if (PROBE_NSA2) add(l, 9, 0); add(l, 3, 0); add(l, 4, 1); add(l, 5, 0); add(l, 6, 0); if (l + 1 < DEPTH) add(l, 7, 1); }
    const int N_PH = np;
#if MK_COOP
    p.ph_lo = 0; p.ph_hi = N_PH;
    void* args[] = {&p};
    hipError_t e = hipLaunchCooperativeKernel((const void*)fwd_kernel, dim3(grid), dim3(NTHREADS), args, LDS_BYTES, stream);
    if (e != hipSuccess) fprintf(stderr, "cooperative launch failed: %s (grid %d)\n", hipGetErrorString(e), grid);
#else
    for (int ph = 0; ph < N_PH; ++ph) {
        p.ph_lo = ph; p.ph_hi = ph + 1;
        hipLaunchKernelGGL(fwd_kernel, dim3(grid), dim3(NTHREADS), LDS_BYTES, stream, p);
    }
#endif
}
```

```cpp
#include <hip/hip_runtime.h>
#include <hip/hip_cooperative_groups.h>
#include <cstdio>
#include <cstdint>
namespace cg = cooperative_groups;
namespace pg8 {
#define PG8_LAS __attribute__((address_space(3)))
typedef unsigned short bf16_t;
typedef short bf16x8 __attribute__((ext_vector_type(8)));
typedef float f32x4 __attribute__((ext_vector_type(4)));
typedef unsigned u32x4 __attribute__((ext_vector_type(4)));
constexpr int BM = 256, BK = 64, HALF = 128, HTB = HALF * BK * 2  , STAGE_BYTES = 8 * HTB, NXCD = 8, WGM = 8;

__host__ __device__ __forceinline__ int lds_byte(int r, int c) { const int st = (r >> 4) * 2 + (c >> 5), rr = r & 15, cc = c & 31, ob = rr * 64 + cc * 2; return st * 1024 + (ob ^ (((ob >> 9) & 1) << 5)); }
__host__ __device__ __forceinline__ void stage_rc(int b, int& R, int& C) { const int st = b / 1024, sb = b % 1024, swz = sb ^ (((sb >> 9) & 1) << 5); R = (st >> 1) * 16 + swz / 64; C = (st & 1) * 32 + (swz % 64) / 2; }
__host__ __device__ __forceinline__ int perm32(int rho) { const int n = rho >> 4, i = rho & 15; return 8 * (i >> 2) + 4 * n + (i & 3); }

struct Unit { int pm, pn; };
struct Gemm { const bf16_t* A; const bf16_t* Bt; int M, N, K; };

struct StaticOrder {
    int nM, nN, nwg, G, c;
    __host__ __device__ void init(int M, int N, int G_, int c_) { nM = M / BM; nN = N / BM; nwg = nM * nN; G = G_; c = c_; }
    __host__ __device__ bool next(int i, Unit& u) const {
        const long L = (long)i * G + c; if (L >= nwg) return false;
        int wgid = (int)L; { const int q = nwg / NXCD, r = nwg % NXCD, xcd = wgid % NXCD, off = wgid / NXCD; wgid = (xcd < r ? xcd * (q + 1) : r * (q + 1) + (xcd - r) * q) + off; }
        const int nig = WGM * nN, gid = wgid / nig, fm = gid * WGM, gsz = (nM - fm) < WGM ? (nM - fm) : WGM;
        u.pm = fm + ((wgid % nig) % gsz); u.pn = (wgid % nig) / gsz; return true;
    }
    __device__ __forceinline__ void a_ready(const Unit&) const {}
    __device__ __forceinline__ void done(const Unit&) const {}
};

__device__ __forceinline__ unsigned cvt_pk_bf16(float lo, float hi) { unsigned r; asm volatile("v_cvt_pk_bf16_f32 %0, %1, %2" : "=v"(r) : "v"(lo), "v"(hi)); return r; }
typedef float f32x2 __attribute__((ext_vector_type(2)));
template <class Epi, class Sched, bool ALIGN_EPI = false, bool SP2 = false>
__device__ __forceinline__ void gemm_phase(PG8_LAS unsigned char* lds, const Gemm g, const Sched& S, const Epi& E, const int tid) {
    const int wid = __builtin_amdgcn_readfirstlane(tid >> 6), lane = tid & 63, wr = wid >> 2, wc = wid & 3, fr = lane & 15, fq = lane >> 4;
    const int K = g.K, nt = K / BK;
    unsigned voffA[2], voffB[2];
#pragma unroll
    for (int i = 0; i < 2; ++i) { int R, C; stage_rc(tid * 16 + i * 8192, R, C); const int Rb = Epi::PERM ? ((R & ~31) + perm32(R & 31)) : R;
        voffA[i] = (unsigned)(R * K + C) * 2u; voffB[i] = (unsigned)(Rb * K + C) * 2u; }
    const size_t kstep = (size_t)(BK * 2);
    const size_t hstep = (size_t)HALF * K * 2;
    const size_t tstep = 2 * hstep;
    const unsigned ldsw = (unsigned)wid * 1024u;
    const int aoff = lds_byte(wr * 64 + fr, fq * 8), boff = lds_byte(wc * 32 + fr, fq * 8);
#define PG8_SA(b, h) (((b) * 2 + (h)) * HTB)
#define PG8_SB(b, h) ((4 + (b) * 2 + (h)) * HTB)
#define PG8_STAGE(bufoff, gbase, voff) do { _Pragma("unroll") for (int _i = 0; _i < 2; ++_i) \
        __builtin_amdgcn_global_load_lds((const unsigned*)((const char*)(gbase) + (voff)[_i]), (PG8_LAS unsigned*)(lds + (bufoff) + ldsw + _i * 8192), 16, 0, 0); } while (0)
#define PG8_LDA(dst, b, h) do { _Pragma("unroll") for (int m = 0; m < 4; ++m) _Pragma("unroll") for (int k = 0; k < 2; ++k) dst[m][k] = *(const PG8_LAS bf16x8*)(lds + PG8_SA(b, h) + aoff + m * 2048 + k * 1024); } while (0)
#define PG8_LDB(dst, b, h) do { _Pragma("unroll") for (int n = 0; n < 2; ++n) _Pragma("unroll") for (int k = 0; k < 2; ++k) dst[n][k] = *(const PG8_LAS bf16x8*)(lds + PG8_SB(b, h) + boff + n * 2048 + k * 1024); } while (0)
#define PG8_MMA(ai, bj, At, Bt) do { __builtin_amdgcn_s_setprio(1); _Pragma("unroll") for (int m = 0; m < 4; ++m) _Pragma("unroll") for (int n = 0; n < 2; ++n) _Pragma("unroll") for (int k = 0; k < 2; ++k) \
        acc[ai][bj][m][n] = __builtin_amdgcn_mfma_f32_16x16x32_bf16(Bt[n][k], At[m][k], acc[ai][bj][m][n], 0, 0, 0); __builtin_amdgcn_s_setprio(0); } while (0)
#define PG8_WAIT_V(n) asm volatile("s_waitcnt vmcnt(" #n ")" ::: "memory")
#define PG8_WAIT_L(n) asm volatile("s_waitcnt lgkmcnt(" #n ")" ::: "memory")
#define PG8_BAR __builtin_amdgcn_s_barrier()
#define PG8_SCHED __builtin_amdgcn_sched_barrier(0)
    Unit cur, nxt; int ui = 0;
    if (!S.next(0, cur)) return;
    f32x4 acc[2][2][4][2];
#pragma unroll
    for (int a = 0; a < 2; ++a)
#pragma unroll
        for (int b = 0; b < 2; ++b)
#pragma unroll
            for (int m = 0; m < 4; ++m)
#pragma unroll
                for (int n = 0; n < 2; ++n) acc[a][b][m][n] = (f32x4){0.f, 0.f, 0.f, 0.f};
    bf16x8 At[4][2], B0[2][2], B1[2][2];
    const char* cA = (const char*)g.A + (size_t)cur.pm * tstep; const char* cB = (const char*)g.Bt + (size_t)cur.pn * tstep;
    S.a_ready(cur);
    if constexpr (SP2) {
        PG8_STAGE(PG8_SB(0, 0), cB, voffB); PG8_STAGE(PG8_SB(0, 1), cB + hstep, voffB); PG8_STAGE(PG8_SA(0, 0), cA, voffA); PG8_STAGE(PG8_SA(0, 1), cA + hstep, voffA);
        if (wr == 1) PG8_BAR;
        PG8_WAIT_V(2); PG8_BAR;
        PG8_STAGE(PG8_SB(1, 0), cB + kstep, voffB); PG8_STAGE(PG8_SA(1, 0), cA + kstep, voffA); PG8_STAGE(PG8_SB(1, 1), cB + hstep + kstep, voffB);
        PG8_WAIT_V(6); PG8_BAR;
    } else {
        PG8_STAGE(PG8_SB(0, 0), cB, voffB); PG8_STAGE(PG8_SA(0, 0), cA, voffA); PG8_STAGE(PG8_SB(0, 1), cB + hstep, voffB); PG8_STAGE(PG8_SA(0, 1), cA + hstep, voffA);
        if (wr == 1) PG8_BAR;
        PG8_WAIT_V(4); PG8_BAR;
        PG8_STAGE(PG8_SB(1, 0), cB + kstep, voffB); PG8_STAGE(PG8_SA(1, 0), cA + kstep, voffA); PG8_STAGE(PG8_SB(1, 1), cB + hstep + kstep, voffB);
        PG8_WAIT_V(6); PG8_BAR;
    }
    for (;;) {
        const bool has_next = S.next(ui + 1, nxt);
        const char* nA = has_next ? (const char*)g.A + (size_t)nxt.pm * tstep : cA; const char* nB = has_next ? (const char*)g.Bt + (size_t)nxt.pn * tstep : cB;
        for (int t = 0; t < nt; t += 2) {
            const bool last = (t == nt - 2);
            const char* a1 = cA + (size_t)(t + 1) * kstep;
            const char* a2 = last ? nA : cA + (size_t)(t + 2) * kstep; const char* b2 = last ? nB : cB + (size_t)(t + 2) * kstep;
            const char* a3 = a2 + kstep; const char* b3 = b2 + kstep;
            if (last && has_next) S.a_ready(nxt);
            if constexpr (SP2) {
            PG8_LDB(B0, 0, 0); PG8_LDB(B1, 0, 1); PG8_SCHED; PG8_LDA(At, 0, 0); PG8_STAGE(PG8_SA(1, 1), a1 + hstep, voffA);
            PG8_WAIT_V(8); PG8_WAIT_L(0); PG8_BAR; PG8_MMA(0, 0, At, B0); PG8_MMA(0, 1, At, B1); PG8_BAR; PG8_SCHED;
            PG8_LDA(At, 0, 1); PG8_STAGE(PG8_SB(0, 0), b2, voffB); PG8_STAGE(PG8_SB(0, 1), b2 + hstep, voffB); PG8_STAGE(PG8_SA(0, 0), a2, voffA);
            PG8_WAIT_V(8); PG8_WAIT_L(0); PG8_BAR; PG8_MMA(1, 0, At, B0); PG8_MMA(1, 1, At, B1); PG8_BAR; PG8_SCHED;
            PG8_LDB(B0, 1, 0); PG8_LDB(B1, 1, 1); PG8_SCHED; PG8_LDA(At, 1, 0); PG8_STAGE(PG8_SA(0, 1), a2 + hstep, voffA);
            PG8_WAIT_V(8); PG8_WAIT_L(0); PG8_BAR; PG8_MMA(0, 0, At, B0); PG8_MMA(0, 1, At, B1); PG8_BAR; PG8_SCHED;
            PG8_LDA(At, 1, 1); PG8_STAGE(PG8_SB(1, 0), b3, voffB); PG8_STAGE(PG8_SB(1, 1), b3 + hstep, voffB); PG8_STAGE(PG8_SA(1, 0), a3, voffA);
            PG8_WAIT_V(8); PG8_WAIT_L(0); PG8_BAR; PG8_MMA(1, 0, At, B0); PG8_MMA(1, 1, At, B1); PG8_BAR; PG8_SCHED;
            } else {
            PG8_LDB(B0, 0, 0); PG8_SCHED; PG8_LDA(At, 0, 0); PG8_STAGE(PG8_SA(1, 1), a1 + hstep, voffA);
            PG8_WAIT_L(8); PG8_BAR; PG8_WAIT_L(0); PG8_MMA(0, 0, At, B0); PG8_BAR; PG8_SCHED;
            PG8_LDB(B1, 0, 1); PG8_STAGE(PG8_SB(0, 0), b2, voffB);
            PG8_BAR; PG8_WAIT_L(0); PG8_MMA(0, 1, At, B1); PG8_BAR;
            PG8_LDA(At, 0, 1); PG8_STAGE(PG8_SA(0, 0), a2, voffA);
            PG8_BAR; PG8_WAIT_L(0); PG8_MMA(1, 0, At, B0); PG8_BAR; PG8_SCHED;
            PG8_STAGE(PG8_SB(0, 1), b2 + hstep, voffB);
            PG8_WAIT_V(6); PG8_BAR; PG8_MMA(1, 1, At, B1); PG8_BAR;
            PG8_LDB(B0, 1, 0); PG8_SCHED; PG8_LDA(At, 1, 0); PG8_STAGE(PG8_SA(0, 1), a2 + hstep, voffA);
            PG8_WAIT_L(8); PG8_BAR; PG8_WAIT_L(0); PG8_MMA(0, 0, At, B0); PG8_BAR; PG8_SCHED;
            PG8_LDB(B1, 1, 1); PG8_STAGE(PG8_SB(1, 0), b3, voffB);
            PG8_BAR; PG8_WAIT_L(0); PG8_MMA(0, 1, At, B1); PG8_BAR;
            PG8_LDA(At, 1, 1); PG8_STAGE(PG8_SA(1, 0), a3, voffA);
            PG8_BAR; PG8_WAIT_L(0); PG8_MMA(1, 0, At, B0); PG8_BAR; PG8_SCHED;
            PG8_STAGE(PG8_SB(1, 1), b3 + hstep, voffB);
            PG8_WAIT_V(6); PG8_BAR; PG8_MMA(1, 1, At, B1); PG8_BAR;
            }
        }
        if constexpr (ALIGN_EPI) { if (wr == 0) PG8_BAR; }
        if constexpr (!Epi::AFTER_DRAIN) { E(acc, cur, wr, wc, fr, fq); S.done(cur); }
        if (!has_next) break;
#pragma unroll
        for (int a = 0; a < 2; ++a)
#pragma unroll
            for (int b = 0; b < 2; ++b)
#pragma unroll
                for (int m = 0; m < 4; ++m)
#pragma unroll
                    for (int n = 0; n < 2; ++n) acc[a][b][m][n] = (f32x4){0.f, 0.f, 0.f, 0.f};
        cur = nxt; cA = nA; cB = nB; ++ui;
        if constexpr (ALIGN_EPI) { if (wr == 1) PG8_BAR; }
    }
    PG8_WAIT_V(0);
    if constexpr (!ALIGN_EPI) { if (wr == 0) PG8_BAR; }
    PG8_BAR;
    if constexpr (Epi::AFTER_DRAIN) { E.fused(acc, cur, wr, wc, fr, fq, lds, wid, lane); S.done(cur); }
#undef PG8_SA
#undef PG8_SB
#undef PG8_STAGE
#undef PG8_LDA
#undef PG8_LDB
#undef PG8_MMA
#undef PG8_WAIT_V
#undef PG8_WAIT_L
#undef PG8_BAR
#undef PG8_SCHED
}
}

#ifndef NSA_ZERO
#define NSA_ZERO 0
#endif

#define LAS __attribute__((address_space(3)))
typedef unsigned short bf16_t;
typedef short bf16x8 __attribute__((ext_vector_type(8)));
typedef short bf16x4 __attribute__((ext_vector_type(4)));
typedef float f32x4 __attribute__((ext_vector_type(4)));
typedef unsigned u32x4 __attribute__((ext_vector_type(4)));
typedef unsigned u32x2 __attribute__((ext_vector_type(2)));

constexpr int BATCH = 32, T = 2048, M = BATCH * T, DM = 1024, DEPTH = 2;
constexpr int NPROJ = 3584, INW = 3352, DFF = 2816;
constexpr int C_HQ = 0, C_HF = 512, C_HI = 1024, C_HG = 1536, C_NQ = 2048, C_KC = 2560, C_VC = 2688, C_KS = 2816, C_VS = 2944, C_KW = 3072, C_VW = 3200, C_GT = 3328;
constexpr float RMS_EPS = 1e-6f;
constexpr size_t MiB = 1u << 20;
constexpr size_t WS_CTL = 0, WS_WIN = 1 * MiB, WS_WOUT = 15 * MiB, WS_WFFI = 19 * MiB, WS_WFFO = 41 * MiB, WS_W1T = 52 * MiB, WS_W2T = 56 * MiB;
constexpr size_t WS_XN = 64 * MiB, WS_MIX = 192 * MiB, WS_LOGF = 320 * MiB, WS_PROJ = 448 * MiB, WS_QN = 896 * MiB;
constexpr size_t AX_KS = 0, AX_KW = 16 * MiB, AX_VST = 32 * MiB, AX_VWT = 48 * MiB, AX_KC = 64 * MiB, AX_VCT = 65 * MiB;
constexpr size_t WS_RS = 960 * MiB, WS_END = 961 * MiB;
constexpr size_t WS_XBAR = WS_CTL + 655360;
constexpr size_t WS_QCTR = WS_CTL + 720896;
constexpr int LDS_BYTES = 143360;
constexpr int NTHREADS = 512;

struct Params { const float* in[17]; float* out; unsigned char* ws; int ph_lo, ph_hi; unsigned char prog[48]; };

__device__ __forceinline__ float bf2f(bf16_t v) { return __uint_as_float(((unsigned)v) << 16); }
__device__ __forceinline__ unsigned pk2(float lo, float hi) { unsigned r; asm("v_cvt_pk_bf16_f32 %0, %1, %2" : "=v"(r) : "v"(lo), "v"(hi)); return r; }
__device__ __forceinline__ bf16_t f2bf(float f) { return (bf16_t)(pk2(f, 0.f) & 0xffffu); }
__device__ __forceinline__ float wave_sum(float v) {
#pragma unroll
    for (int o = 1; o < 64; o <<= 1) v += __shfl_xor(v, o);
    return v;
}
__device__ __forceinline__ float fast_sigmoid(float x) { return __builtin_amdgcn_rcpf(1.f + __expf(-x)); }
__device__ __forceinline__ float fast_silu(float x) { return x * fast_sigmoid(x); }
#define LDS_WAIT() asm volatile("s_waitcnt lgkmcnt(0)" ::: "memory")
#define LDS_BARRIER() do { asm volatile("s_waitcnt lgkmcnt(0)" ::: "memory"); __builtin_amdgcn_s_barrier(); asm volatile("" ::: "memory"); } while (0)
#define MFMA16(a, b, c) __builtin_amdgcn_mfma_f32_16x16x32_bf16((a), (b), (c), 0, 0, 0)

struct EpiProj {
    static constexpr bool PERM = true, AFTER_DRAIN = false;
    bf16_t* P; float* LOGF; const float* lb; const float* rss;
    __device__ __forceinline__ void operator()(const f32x4 (&acc)[2][2][4][2], const pg8::Unit& u, int wr, int wc, int fr, int fq) const {
        const int row0 = u.pm * 256 + wr * 64 + fr;
        const int col0 = u.pn * 256 + wc * 32 + 8 * fq;
        float rstdv[2][4];
#pragma unroll
        for (int ai = 0; ai < 2; ++ai)
#pragma unroll
            for (int m = 0; m < 4; ++m) rstdv[ai][m] = rss[row0 + ai * 128 + m * 16];
#pragma unroll
        for (int ai = 0; ai < 2; ++ai)
#pragma unroll
            for (int m = 0; m < 4; ++m) rstdv[ai][m] = __builtin_amdgcn_rsqf(rstdv[ai][m] * (1.f / DM) + RMS_EPS);
        __builtin_amdgcn_sched_barrier(0);
        if (u.pn == 2 || u.pn == 3) {
#pragma unroll
            for (int bj = 0; bj < 2; ++bj) {
                const int cc = col0 + bj * 128 - C_HF;
                const f32x4 l0 = *(const f32x4*)(lb + cc), l1 = *(const f32x4*)(lb + cc + 4);
#pragma unroll
                for (int ai = 0; ai < 2; ++ai)
#pragma unroll
                    for (int m = 0; m < 4; ++m) {
                        const float rstd = rstdv[ai][m];
                        const f32x4 z0 = acc[ai][bj][m][0] * rstd, z1 = acc[ai][bj][m][1] * rstd;
                        f32x4 o0, o1;
#pragma unroll
                        for (int e = 0; e < 4; ++e) {
                            const float s0 = __builtin_amdgcn_rcpf(1.f + __expf(-z0[e])), s1 = __builtin_amdgcn_rcpf(1.f + __expf(-z1[e]));
                            o0[e] = __logf(l0[e] + (1.f - l0[e]) * s0); o1[e] = __logf(l1[e] + (1.f - l1[e]) * s1);
                        }
                        float* dst = LOGF + (size_t)(row0 + ai * 128 + m * 16) * 512 + cc;
                        *(f32x4*)dst = o0; *(f32x4*)(dst + 4) = o1;
                    }
            }
        } else {
#pragma unroll
            for (int ai = 0; ai < 2; ++ai)
#pragma unroll
                for (int m = 0; m < 4; ++m) {
                    bf16_t* rowp = P + (size_t)(row0 + ai * 128 + m * 16) * NPROJ + col0;
                    const float rstd = rstdv[ai][m];
#pragma unroll
                    for (int bj = 0; bj < 2; ++bj) {
                        const f32x4 v0 = acc[ai][bj][m][0] * rstd, v1 = acc[ai][bj][m][1] * rstd;
                        u32x4 w; w.x = pk2(v0[0], v0[1]); w.y = pk2(v0[2], v0[3]); w.z = pk2(v1[0], v1[1]); w.w = pk2(v1[2], v1[3]);
                        *(u32x4*)(rowp + bj * 128) = w;
                    }
                }
        }
    }
};
struct EpiRes {
    static constexpr bool PERM = true, AFTER_DRAIN = false;
    bf16_t* HB; float* outf; float* rss;
    __device__ __forceinline__ void operator()(const f32x4 (&acc)[2][2][4][2], const pg8::Unit& u, int wr, int wc, int fr, int fq) const {
        const int row0 = u.pm * 256 + wr * 64 + fr;
        const int col0 = u.pn * 256 + wc * 32 + 8 * fq;
        u32x4 buf[2][2][2];
#define ERES_LOAD(slot, q) do { _Pragma("unroll") for (int mm = 0; mm < 2; ++mm) _Pragma("unroll") for (int bj = 0; bj < 2; ++bj) \
            buf[slot][mm][bj] = *(const u32x4*)(HB + (size_t)(row0 + ((q) >> 1) * 128 + (2 * ((q) & 1) + mm) * 16) * DM + col0 + bj * 128); } while (0)
        ERES_LOAD(0, 0); ERES_LOAD(1, 1);
#pragma unroll
        for (int q = 0; q < 4; ++q) {
            const int ai = q >> 1, slot = q & 1;
#pragma unroll
            for (int mm = 0; mm < 2; ++mm) {
                const int m = 2 * (q & 1) + mm;
                const int row = row0 + ai * 128 + m * 16;
                const size_t off = (size_t)row * DM + col0;
                float ssq = 0.f;
#pragma unroll
                for (int bj = 0; bj < 2; ++bj) {
                    const u32x4 hb = buf[slot][mm][bj];
                    f32x4 o0, o1;
                    o0[0] = __uint_as_float(hb.x << 16) + acc[ai][bj][m][0][0]; o0[1] = __uint_as_float(hb.x & 0xffff0000u) + acc[ai][bj][m][0][1];
                    o0[2] = __uint_as_float(hb.y << 16) + acc[ai][bj][m][0][2]; o0[3] = __uint_as_float(hb.y & 0xffff0000u) + acc[ai][bj][m][0][3];
                    o1[0] = __uint_as_float(hb.z << 16) + acc[ai][bj][m][1][0]; o1[1] = __uint_as_float(hb.z & 0xffff0000u) + acc[ai][bj][m][1][1];
                    o1[2] = __uint_as_float(hb.w << 16) + acc[ai][bj][m][1][2]; o1[3] = __uint_as_float(hb.w & 0xffff0000u) + acc[ai][bj][m][1][3];
                    if (outf) { *(f32x4*)(outf + off + bj * 128) = o0; *(f32x4*)(outf + off + bj * 128 + 4) = o1; }
                    else {
                        ssq += (o0[0] * o0[0] + o0[1] * o0[1]) + (o0[2] * o0[2] + o0[3] * o0[3]) + (o1[0] * o1[0] + o1[1] * o1[1]) + (o1[2] * o1[2] + o1[3] * o1[3]);
                        u32x4 w; w.x = pk2(o0[0], o0[1]); w.y = pk2(o0[2], o0[3]); w.z = pk2(o1[0], o1[1]); w.w = pk2(o1[2], o1[3]);
                        *(u32x4*)(HB + off + bj * 128) = w;
                    }
                }
                if (!outf) {
                    ssq += __shfl_xor(ssq, 16); ssq += __shfl_xor(ssq, 32);
                    if (fq == 0) (void)__hip_atomic_fetch_add(rss + row, ssq, __ATOMIC_RELAXED, __HIP_MEMORY_SCOPE_AGENT);
                }
            }
            if (q + 2 < 4) { if (slot == 0) ERES_LOAD(0, q + 2); else ERES_LOAD(1, q + 2); }
            __builtin_amdgcn_sched_barrier(0);
        }
#undef ERES_LOAD
    }
};
struct EpiSwiGLU {
    static constexpr bool PERM = true, AFTER_DRAIN = false;
    bf16_t* A; const float* rss;
    __device__ __forceinline__ void operator()(const f32x4 (&acc)[2][2][4][2], const pg8::Unit& u, int wr, int wc, int fr, int fq) const {
        const int row0 = u.pm * 256 + wr * 64 + fr;
        const int col0 = u.pn * 128 + wc * 32 + 8 * fq;
        float rstdv[2][4];
#pragma unroll
        for (int ai = 0; ai < 2; ++ai)
#pragma unroll
            for (int m = 0; m < 4; ++m) rstdv[ai][m] = rss[row0 + ai * 128 + m * 16];
#pragma unroll
        for (int ai = 0; ai < 2; ++ai)
#pragma unroll
            for (int m = 0; m < 4; ++m) rstdv[ai][m] = __builtin_amdgcn_rsqf(rstdv[ai][m] * (1.f / DM) + RMS_EPS);
        __builtin_amdgcn_sched_barrier(0);
#pragma unroll
        for (int ai = 0; ai < 2; ++ai)
#pragma unroll
            for (int m = 0; m < 4; ++m) {
                const float rstd = rstdv[ai][m];
                const f32x4 g0 = acc[ai][0][m][0] * rstd, g1 = acc[ai][0][m][1] * rstd, u0 = acc[ai][1][m][0] * rstd, u1 = acc[ai][1][m][1] * rstd;
                float r[8];
#pragma unroll
                for (int e = 0; e < 4; ++e) { r[e] = fast_silu(g0[e]) * u0[e]; r[4 + e] = fast_silu(g1[e]) * u1[e]; }
                u32x4 w; w.x = pk2(r[0], r[1]); w.y = pk2(r[2], r[3]); w.z = pk2(r[4], r[5]); w.w = pk2(r[6], r[7]);
                *(u32x4*)(A + (size_t)(row0 + ai * 128 + m * 16) * DFF + col0) = w;
            }
    }
};

__device__ __forceinline__ void transpose_item(const float* __restrict__ W, int K, int N, int nblk, bf16_t* WT, int mode, const float* gk, LAS float* scr, int item, int lane) {
    const int kb = item / nblk, nb = item % nblk, k0 = 64 * kb, n0 = 32 * nb;
    const int n = n0 + (lane & 31);
#pragma unroll 8
    for (int i = 0; i < 32; ++i) { const int kk = 2 * i + (lane >> 5); scr[kk * 33 + (lane & 31)] = (n < N) ? W[(size_t)(k0 + kk) * N + n] * (gk ? gk[k0 + kk] : 1.f) : 0.f; }
    LDS_WAIT();
    const int c = lane & 7;
#pragma unroll
    for (int j = 0; j < 4; ++j) {
        const int nl = (lane >> 3) + 8 * j, nn = n0 + nl;
        int row = nn;
        if (mode == 1) row = (nn < DFF) ? ((nn >> 7) * 256 + (nn & 127)) : ((((nn - DFF) >> 7) * 256) + 128 + ((nn - DFF) & 127));
        const LAS float* s = scr + (8 * c) * 33 + nl;
        u32x4 o; o.x = pk2(s[0 * 33], s[1 * 33]); o.y = pk2(s[2 * 33], s[3 * 33]); o.z = pk2(s[4 * 33], s[5 * 33]); o.w = pk2(s[6 * 33], s[7 * 33]);
        *(u32x4*)(WT + (size_t)row * K + k0 + 8 * c) = o;
    }
    LDS_WAIT();
}
__device__ __forceinline__ void gain_row_to_bf16(const float* xrow, bf16_t* orow, float* rs, int lane) {
    const f32x4* xr = (const f32x4*)xrow + lane;
    f32x4 v[4]; float s = 0.f;
#pragma unroll
    for (int j = 0; j < 4; ++j) { v[j] = xr[64 * j]; s += (v[j].x * v[j].x + v[j].y * v[j].y) + (v[j].z * v[j].z + v[j].w * v[j].w); }
    s = wave_sum(s);
    if (lane == 0) *rs = s;
    unsigned long long* o8 = (unsigned long long*)orow + lane;
#pragma unroll
    for (int j = 0; j < 4; ++j) o8[64 * j] = (unsigned long long)pk2(v[j].x, v[j].y) | ((unsigned long long)pk2(v[j].z, v[j].w) << 32);
}
__device__ __forceinline__ void weights_phase(const Params& p, LAS unsigned char* lds, int gw, int NGW, int wave, int lane, int l) {
    LAS float* scr = (LAS float*)(lds + wave * 16384);
    unsigned char* ws = p.ws;
    constexpr int I_IN = 16 * 112, I_OUT = 16 * 32, I_FFI = 16 * 176, I_FFO = 44 * 32, I_W1 = 32 * 8, I_W2 = 4 * 2;
    constexpr int PER_LAYER = I_IN + I_OUT + I_FFI + I_FFO + 2 * I_W1 + 2 * I_W2;
    for (int it = gw; it < PER_LAYER; it += NGW) {
        int r = it;
        if (r < I_IN) { transpose_item(p.in[1] + (size_t)l * DM * INW, DM, INW, 112, (bf16_t*)(ws + WS_WIN) + (size_t)l * NPROJ * DM, 0, p.in[15] + l * DM, scr, r, lane); continue; } r -= I_IN;
        if (r < I_OUT) { transpose_item(p.in[2] + (size_t)l * DM * DM, DM, DM, 32, (bf16_t*)(ws + WS_WOUT) + (size_t)l * DM * DM, 0, nullptr, scr, r, lane); continue; } r -= I_OUT;
        if (r < I_FFI) { transpose_item(p.in[13] + (size_t)l * DM * 2 * DFF, DM, 2 * DFF, 176, (bf16_t*)(ws + WS_WFFI) + (size_t)l * 2 * DFF * DM, 1, p.in[16] + l * DM, scr, r, lane); continue; } r -= I_FFI;
        if (r < I_FFO) { transpose_item(p.in[14] + (size_t)l * DFF * DM, DFF, DM, 32, (bf16_t*)(ws + WS_WFFO) + (size_t)l * DM * DFF, 0, nullptr, scr, r, lane); continue; } r -= I_FFO;
        if (r < I_W1) { transpose_item(p.in[8] + (size_t)l * 2048 * 256, 2048, 256, 8, (bf16_t*)(ws + WS_W1T) + (size_t)(l * 2 + 0) * 256 * 2048, 0, nullptr, scr, r, lane); continue; } r -= I_W1;
        if (r < I_W1) { transpose_item(p.in[11] + (size_t)l * 2048 * 256, 2048, 256, 8, (bf16_t*)(ws + WS_W1T) + (size_t)(l * 2 + 1) * 256 * 2048, 0, nullptr, scr, r, lane); continue; } r -= I_W1;
        if (r < I_W2) { transpose_item(p.in[9] + (size_t)l * 256 * 64, 256, 64, 2, (bf16_t*)(ws + WS_W2T) + (size_t)(l * 2 + 0) * 64 * 256, 0, nullptr, scr, r, lane); continue; } r -= I_W2;
        transpose_item(p.in[12] + (size_t)l * 256 * 64, 256, 64, 2, (bf16_t*)(ws + WS_W2T) + (size_t)(l * 2 + 1) * 64 * 256, 0, nullptr, scr, r, lane);
    }
}
__device__ __forceinline__ void prologue_phase(const Params& p, LAS unsigned char* lds, int gw, int NGW, int wave, int lane) {
    unsigned char* ws = p.ws;
    for (int l = 0; l < DEPTH; ++l) weights_phase(p, lds, gw, NGW, wave, lane, l);
    if (gw == 0) {
        unsigned* ctl = (unsigned*)(ws + WS_CTL);
        if (lane < 48) ctl[64 * lane] = 0u;
        for (int i = lane; i < 48 * 8; i += 64) ((unsigned*)(ws + WS_QCTR))[64 * i] = 0u;
        {
            float* M0T = (float*)(ws + WS_CTL + 24576);
            for (int l = 0; l < DEPTH; ++l) {
                float gq = fabsf(p.in[5][l * 64 + lane]), g0 = fabsf(p.in[6][l * 192 + lane]), g1 = fabsf(p.in[6][l * 192 + 64 + lane]), g2 = fabsf(p.in[6][l * 192 + 128 + lane]);
#pragma unroll
                for (int ofs = 1; ofs < 64; ofs <<= 1) { gq = fmaxf(gq, __shfl_xor(gq, ofs)); g0 = fmaxf(g0, __shfl_xor(g0, ofs)); g1 = fmaxf(g1, __shfl_xor(g1, ofs)); g2 = fmaxf(g2, __shfl_xor(g2, ofs)); }
                const float c = 64.f * 0.125f * 1.4426950408889634f * 1.001f;
                if (lane == 0) { M0T[4 * l + 0] = c * gq * g0; M0T[4 * l + 1] = c * gq * g1; M0T[4 * l + 2] = c * gq * g2; }
            }
        }
        float* LB = (float*)(ws + WS_CTL + 16384);
        for (int c = lane; c < 512; c += 64) { const float l0 = p.in[3][c], l1 = p.in[3][512 + c]; LB[c] = 0.f; LB[512 + c] = 1.f / (1.f + expf(l0 - l1)); }
    }
    {
        float* CS = (float*)(ws + WS_CTL + 65536);
        for (int idx = gw * 64 + lane; idx < T * 32; idx += NGW * 64) { float sn, cs; sincosf((float)(idx >> 5) * exp2f(-(float)(idx & 31) * 0.41524101186092034f), &sn, &cs); CS[2 * idx] = cs; CS[2 * idx + 1] = sn; }
    }
    float* RS = (float*)(ws + WS_RS);
    for (int m = gw; m < M; m += 4 * NGW) {
        f32x4 v[4][4]; float s[4];
#pragma unroll
        for (int r = 0; r < 4; ++r) { const f32x4* xr = (const f32x4*)(p.in[0] + (size_t)(m + r * NGW) * DM) + lane;
#pragma unroll
            for (int j = 0; j < 4; ++j) v[r][j] = xr[64 * j]; }
#pragma unroll
        for (int r = 0; r < 4; ++r) { s[r] = 0.f;
#pragma unroll
            for (int j = 0; j < 4; ++j) s[r] += (v[r][j].x * v[r][j].x + v[r][j].y * v[r][j].y) + (v[r][j].z * v[r][j].z + v[r][j].w * v[r][j].w); }
#pragma unroll
        for (int o = 1; o < 64; o <<= 1) {
#pragma unroll
            for (int r = 0; r < 4; ++r) s[r] += __shfl_xor(s[r], o); }
#pragma unroll
        for (int r = 0; r < 4; ++r) {
            if (lane == 0) RS[m + r * NGW] = s[r];
            unsigned long long* o8 = (unsigned long long*)((bf16_t*)(ws + WS_XN) + (size_t)(m + r * NGW) * DM) + lane;
#pragma unroll
            for (int j = 0; j < 4; ++j) o8[64 * j] = (unsigned long long)pk2(v[r][j].x, v[r][j].y) | ((unsigned long long)pk2(v[r][j].z, v[r][j].w) << 32);
        }
    }
    for (int i = gw * 64 + lane; i < 3 * M; i += NGW * 64) RS[M + i] = 0.f;
}

constexpr float ROPE_C = 0.41524101186092034f;
constexpr float QSCALE = 0.125f * 1.4426950408889634f;
__device__ __forceinline__ void prep_item(const Params& p, int l, int item, LAS unsigned char* lds, int tid, int wave, int lane) {
    const int b = item >> 5, tc = item & 31, m0 = b * T + tc * 64;
    unsigned char* ws = p.ws; unsigned char* aux = (unsigned char*)p.out;
    const bf16_t* PROJ = (const bf16_t*)(ws + WS_PROJ);
    LAS bf16_t* Vt = (LAS bf16_t*)lds;
#pragma unroll
    for (int k = 0; k < 4; ++k) {
        const int c = tid + 512 * k, token = c >> 5, part = c & 31;
        const int col = part < 16 ? C_VS + part * 8 : C_VW + (part - 16) * 8;
        const u32x4 v = *(const u32x4*)(PROJ + (size_t)(m0 + token) * NPROJ + col);
        *(LAS u32x4*)(Vt + token * 264 + part * 8) = v;
    }
    {
        const float* CS = (const float*)(ws + WS_CTL + 65536);
        const int hsel = lane >> 3, i0 = (lane & 7) * 4, kh = hsel & 3;
        const float* qg = p.in[5] + l * 64; const float* kgp = p.in[6] + l * 192 + (kh < 2 ? 64 : 128);
        const f32x4 gqa = *(const f32x4*)(qg + i0), gqb = *(const f32x4*)(qg + 32 + i0), gka = *(const f32x4*)(kgp + i0), gkb = *(const f32x4*)(kgp + 32 + i0);
        bf16_t* QN = (bf16_t*)(ws + WS_QN);
        bf16_t* KX = (bf16_t*)(aux + (kh < 2 ? AX_KS : AX_KW));
#define PREP_ROPE(srcp, dstp, tpos, ga, gb, sc) do { \
            const u32x2 r1 = *(const u32x2*)(srcp), r2 = *(const u32x2*)((srcp) + 32); \
            const f32x4 c01 = *(const f32x4*)(CS + (size_t)(tpos) * 64 + 2 * i0), c23 = *(const f32x4*)(CS + (size_t)(tpos) * 64 + 2 * i0 + 4); \
            f32x4 x1, x2; x1[0] = __uint_as_float(r1.x << 16); x1[1] = __uint_as_float(r1.x & 0xffff0000u); x1[2] = __uint_as_float(r1.y << 16); x1[3] = __uint_as_float(r1.y & 0xffff0000u); \
            x2[0] = __uint_as_float(r2.x << 16); x2[1] = __uint_as_float(r2.x & 0xffff0000u); x2[2] = __uint_as_float(r2.y << 16); x2[3] = __uint_as_float(r2.y & 0xffff0000u); \
            float ss = (x1[0] * x1[0] + x1[1] * x1[1]) + (x1[2] * x1[2] + x1[3] * x1[3]) + (x2[0] * x2[0] + x2[1] * x2[1]) + (x2[2] * x2[2] + x2[3] * x2[3]); \
            ss += __shfl_xor(ss, 1); ss += __shfl_xor(ss, 2); ss += __shfl_xor(ss, 4); \
            const float rs_ = (sc) / sqrtf(ss * (1.f / 64.f) + RMS_EPS); \
            const f32x4 y1 = x1 * (ga) * rs_, y2 = x2 * (gb) * rs_; \
            const f32x4 cc = (f32x4){c01[0], c01[2], c23[0], c23[2]}, sn = (f32x4){c01[1], c01[3], c23[1], c23[3]}; \
            const f32x4 o1 = y1 * cc - y2 * sn, o2 = y1 * sn + y2 * cc; \
            u32x2 w1, w2; w1.x = pk2(o1[0], o1[1]); w1.y = pk2(o1[2], o1[3]); w2.x = pk2(o2[0], o2[1]); w2.y = pk2(o2[2], o2[3]); \
            *(u32x2*)(dstp) = w1; *(u32x2*)((dstp) + 32) = w2; } while (0)
#pragma unroll 4
        for (int tl = 0; tl < 8; ++tl) {
            const int token = 8 * wave + tl, t = tc * 64 + token;
            const bf16_t* sp = PROJ + (size_t)(m0 + token) * NPROJ + C_NQ + hsel * 64 + i0;
            bf16_t* dp = QN + (((size_t)(b * 2 + (hsel >> 2)) * T + t) * 4 + (hsel & 3)) * 64 + i0;
            PREP_ROPE(sp, dp, t, gqa, gqb, QSCALE);
        }
#pragma unroll
        for (int tp = 0; tp < 4; ++tp) {
            const int token = 8 * wave + 2 * tp + (lane >> 5), t = tc * 64 + token;
            const bf16_t* sp = PROJ + (size_t)(m0 + token) * NPROJ + (kh < 2 ? C_KS + kh * 64 : C_KW + (kh - 2) * 64) + i0;
            bf16_t* dp = KX + ((size_t)(b * 2 + (kh & 1)) * T + t) * 64 + i0;
            PREP_ROPE(sp, dp, t, gka, gkb, 1.f);
        }
#undef PREP_ROPE
    }
    LDS_BARRIER();
    {
        const int r = tid >> 1, h2 = tid & 1, typ = r >> 7, g = (r >> 6) & 1, d = r & 63;
        bf16_t* dst = (bf16_t*)(aux + (typ ? AX_VWT : AX_VST)) + (((size_t)(b * 2 + g) * 32 + tc) * 64 + d) * 64 + 32 * h2;
#pragma unroll
        for (int q4 = 0; q4 < 4; ++q4) {
            unsigned w[4];
#pragma unroll
            for (int k = 0; k < 4; ++k) {
                const unsigned lo = Vt[(32 * h2 + 8 * q4 + 2 * k) * 264 + r], hi = Vt[(32 * h2 + 8 * q4 + 2 * k + 1) * 264 + r];
                w[k] = lo | (hi << 16);
            }
            *(u32x4*)(dst + 8 * q4) = (u32x4){w[0], w[1], w[2], w[3]};
        }
    }
    LDS_BARRIER();
}

__device__ __forceinline__ void compress_item(const Params& p, int l, int ci, LAS unsigned char* lds, int tid, int wave, int lane) {
    const int half = ci & 1, kv = (ci >> 1) & 1, bg = ci >> 2, b = bg >> 1, g = bg & 1;
    const int quad = lane >> 4, r16 = lane & 15;
    unsigned char* ws = p.ws; unsigned char* aux = (unsigned char*)p.out;
    const bf16_t* src = (const bf16_t*)(ws + WS_PROJ) + (size_t)b * T * NPROJ + (kv ? C_VC : C_KC) + g * 64;
    const float* pe = p.in[kv ? 10 : 7] + l * 32 * 64;
    const bf16_t* W1T = (const bf16_t*)(ws + WS_W1T) + (size_t)(l * 2 + kv) * 256 * 2048;
    const bf16_t* W2T = (const bf16_t*)(ws + WS_W2T) + (size_t)(l * 2 + kv) * 64 * 256;
    LAS bf16_t* As = (LAS bf16_t*)lds;
    LAS bf16_t* Bs = (LAS bf16_t*)(lds + 17408);
    LAS bf16_t* Hs = (LAS bf16_t*)(lds + 87040);
    LAS float* Os = (LAS float*)(lds + 120832);
    f32x4 acc[4][2];
#pragma unroll
    for (int mt = 0; mt < 4; ++mt) { acc[mt][0] = (f32x4){0.f, 0.f, 0.f, 0.f}; acc[mt][1] = (f32x4){0.f, 0.f, 0.f, 0.f}; }
    const int ar = tid >> 3, ach = tid & 7, n_a = 64 * half + ar;
    u32x4 raw[2], wv[2][4]; f32x4 pe0[2], pe1[2];
#define CMP_LOAD(st_) do { _Pragma("unroll") for (int h_ = 0; h_ < 2; ++h_) { const int ls_ = 2 * (st_) + h_; int tok = 16 * n_a + ls_; tok = tok > T - 1 ? T - 1 : tok; \
        raw[h_] = *(const u32x4*)(src + (size_t)tok * NPROJ + ach * 8); pe0[h_] = *(const f32x4*)(pe + ls_ * 64 + ach * 8); pe1[h_] = *(const f32x4*)(pe + ls_ * 64 + ach * 8 + 4); \
        _Pragma("unroll") for (int k = 0; k < 4; ++k) wv[h_][k] = *(const u32x4*)(W1T + (size_t)(ar + 64 * k) * 2048 + ls_ * 64 + ach * 8); } } while (0)
    CMP_LOAD(0);
    for (int st = 0; st < 16; ++st) {
        LDS_BARRIER();
#pragma unroll
        for (int h_ = 0; h_ < 2; ++h_) {
            u32x4 o;
            o.x = pk2(__uint_as_float(raw[h_].x << 16) + pe0[h_][0], __uint_as_float(raw[h_].x & 0xffff0000u) + pe0[h_][1]);
            o.y = pk2(__uint_as_float(raw[h_].y << 16) + pe0[h_][2], __uint_as_float(raw[h_].y & 0xffff0000u) + pe0[h_][3]);
            o.z = pk2(__uint_as_float(raw[h_].z << 16) + pe1[h_][0], __uint_as_float(raw[h_].z & 0xffff0000u) + pe1[h_][1]);
            o.w = pk2(__uint_as_float(raw[h_].w << 16) + pe1[h_][2], __uint_as_float(raw[h_].w & 0xffff0000u) + pe1[h_][3]);
            *(LAS u32x4*)(As + ar * 136 + 64 * h_ + ach * 8) = o;
#pragma unroll
            for (int k = 0; k < 4; ++k) *(LAS u32x4*)(Bs + (ar + 64 * k) * 136 + 64 * h_ + ach * 8) = wv[h_][k];
        }
        if (st + 1 < 16) CMP_LOAD(st + 1);
        LDS_BARRIER();
#pragma unroll
        for (int kb = 0; kb < 4; ++kb) {
            bf16x8 bfr[2];
#pragma unroll
            for (int nt = 0; nt < 2; ++nt) bfr[nt] = *(const LAS bf16x8*)(Bs + (32 * wave + 16 * nt + r16) * 136 + 32 * kb + 8 * quad);
#pragma unroll
            for (int mt = 0; mt < 4; ++mt) {
                const bf16x8 a = *(const LAS bf16x8*)(As + (16 * mt + r16) * 136 + 32 * kb + 8 * quad);
#pragma unroll
                for (int nt = 0; nt < 2; ++nt) acc[mt][nt] = MFMA16(a, bfr[nt], acc[mt][nt]);
            }
        }
    }
#undef CMP_LOAD
    LDS_BARRIER();
#pragma unroll
    for (int mt = 0; mt < 4; ++mt)
#pragma unroll
        for (int nt = 0; nt < 2; ++nt)
#pragma unroll
            for (int e = 0; e < 4; ++e) { const float x = acc[mt][nt][e]; Hs[(16 * mt + 4 * quad + e) * 264 + 32 * wave + 16 * nt + r16] = f2bf(x / (1.f + expf(-x))); }
    LDS_BARRIER();
    {
        const int mt = wave >> 1;
        f32x4 o2[2]; o2[0] = (f32x4){0.f, 0.f, 0.f, 0.f}; o2[1] = (f32x4){0.f, 0.f, 0.f, 0.f};
#pragma unroll
        for (int kb = 0; kb < 8; ++kb) {
            const bf16x8 a = *(const LAS bf16x8*)(Hs + (16 * mt + r16) * 264 + 32 * kb + 8 * quad);
#pragma unroll
            for (int dd = 0; dd < 2; ++dd) {
                const int dt = 2 * (wave & 1) + dd;
                const bf16x8 bw = *(const bf16x8*)(W2T + (size_t)(16 * dt + r16) * 256 + 32 * kb + 8 * quad);
                o2[dd] = MFMA16(a, bw, o2[dd]);
            }
        }
#pragma unroll
        for (int dd = 0; dd < 2; ++dd)
#pragma unroll
            for (int e = 0; e < 4; ++e) Os[(16 * mt + 4 * quad + e) * 65 + 16 * (2 * (wave & 1) + dd) + r16] = o2[dd][e];
    }
    LDS_BARRIER();
    if (kv == 0) {
        const int row = tid >> 3, sub = tid & 7, n = 64 * half + row;
        float x1[4], x2[4], ss = 0.f;
#pragma unroll
        for (int k = 0; k < 4; ++k) { x1[k] = Os[row * 65 + 4 * sub + k]; x2[k] = Os[row * 65 + 32 + 4 * sub + k]; ss += x1[k] * x1[k] + x2[k] * x2[k]; }
        ss += __shfl_xor(ss, 1); ss += __shfl_xor(ss, 2); ss += __shfl_xor(ss, 4);
        const float rstd = 1.f / sqrtf(ss * (1.f / 64.f) + RMS_EPS);
        const float* kg = p.in[6] + l * 192;
        const float* CSt = (const float*)(ws + WS_CTL + 65536);
        bf16_t* dst = (bf16_t*)(aux + AX_KC) + ((size_t)bg * 128 + n) * 64;
#pragma unroll
        for (int k = 0; k < 4; ++k) {
            const int i = 4 * sub + k;
            const float cs = CSt[(16 * (n > 126 ? 126 : n) + 31) * 64 + 2 * i], sn = CSt[(16 * (n > 126 ? 126 : n) + 31) * 64 + 2 * i + 1];
            const float y1 = x1[k] * rstd * kg[i], y2 = x2[k] * rstd * kg[i + 32];
            float o1 = y1 * cs - y2 * sn, o2v = y1 * sn + y2 * cs;
            if (n >= 127) { o1 = 0.f; o2v = 0.f; }
            dst[i] = f2bf(o1); dst[i + 32] = f2bf(o2v);
        }
    } else {
        const int d = tid >> 3, sub = tid & 7;
        float v[8];
#pragma unroll
        for (int k = 0; k < 8; ++k) { const int r = 8 * sub + k, n = 64 * half + r; v[k] = (n >= 127) ? 0.f : Os[r * 65 + d]; }
        u32x4 o; o.x = pk2(v[0], v[1]); o.y = pk2(v[2], v[3]); o.z = pk2(v[4], v[5]); o.w = pk2(v[6], v[7]);
        *(u32x4*)((bf16_t*)(aux + AX_VCT) + ((size_t)bg * 64 + d) * 128 + 64 * half + 8 * sub) = o;
    }
    LDS_BARRIER();
}

__device__ __forceinline__ void hgrn_item(const Params& p, int l, int item, LAS unsigned char* lds, int tid, int wave, int lane) {
    const int b = item >> 2, h = item & 3;
    const int quad = lane >> 4, r16 = lane & 15;
    unsigned char* ws = p.ws; unsigned char* aux = (unsigned char*)p.out;
    const bf16_t* PROJ = (const bf16_t*)(ws + WS_PROJ);
    const float* LOGF = (const float*)(ws + WS_LOGF);
    bf16_t* MIX = (bf16_t*)(ws + WS_MIX);
    const float* gnorm = p.in[4] + l * 128;
    LAS bf16_t* Qt = (LAS bf16_t*)lds;
    LAS bf16_t* Kt = (LAS bf16_t*)(lds + 17408);
    LAS float* Ob = (LAS float*)lds;
    LAS bf16_t* Qh = (LAS bf16_t*)(lds + 34816);
    LAS bf16_t* KhT = (LAS bf16_t*)(lds + 52224);
    LAS bf16_t* VT = (LAS bf16_t*)(lds + 70656);
    LAS bf16_t* As = (LAS bf16_t*)(lds + 89088);
    LAS bf16_t* ST = (LAS bf16_t*)(lds + 98304);
    LAS float* TOT = (LAS float*)(lds + 133120);
    LAS float* DEC = (LAS float*)(lds + 135168);
    const int d = tid & 127, seg = tid >> 7;
    for (int i = tid; i < 34816 / 16; i += NTHREADS) ((LAS u32x4*)ST)[i] = (u32x4){0u, 0u, 0u, 0u};
    f32x4 S[8];
#pragma unroll
    for (int vt = 0; vt < 8; ++vt) S[vt] = (f32x4){0.f, 0.f, 0.f, 0.f};
    __syncthreads();
    for (int c = 0; c < 32; ++c) {
        const int m0 = b * T + c * 64;
        float bl[16], qs[16], lf[16];
        {
            float cum = 0.f;
#pragma unroll
            for (int r = 0; r < 16; ++r) {
                const int row = seg * 16 + r;
                const bf16_t* pr = PROJ + (size_t)(m0 + row) * NPROJ + h * 128 + d;
                lf[r] = LOGF[(size_t)(m0 + row) * 512 + h * 128 + d];
                const float q = bf2f(pr[C_HQ]);
                qs[r] = q * __builtin_amdgcn_rcpf(1.f + __expf(-q));
                VT[d * 72 + row] = pr[C_HI];
                cum += lf[r]; bl[r] = cum;
            }
            TOT[seg * 128 + d] = cum;
        }
        LDS_BARRIER();
        {
            const float t0 = TOT[d], t1 = TOT[128 + d], t2 = TOT[256 + d], t3 = TOT[384 + d];
            const float off = seg == 0 ? 0.f : (seg == 1 ? t0 : (seg == 2 ? t0 + t1 : t0 + t1 + t2));
            const float bmid = t0 + t1, blast = (t0 + t1) + (t2 + t3);
            if (seg == 0) DEC[d] = __expf(blast);
#pragma unroll
            for (int r = 0; r < 16; ++r) {
                const int row = seg * 16 + r;
                const float bb = off + bl[r];
                const float k = 1.f - __expf(lf[r]);
                Qt[row * 136 + d] = f2bf(qs[r] * __expf(bb - bmid));
                Kt[row * 136 + d] = f2bf(k * __expf(bmid - bb));
                Qh[row * 136 + d] = f2bf(qs[r] * __expf(bb));
                KhT[d * 72 + row] = f2bf(k * __expf(blast - bb));
            }
        }
        LDS_BARRIER();
        {
            const int tt = wave >> 1, st0 = 2 * (wave & 1);
            f32x4 a2[2]; a2[0] = (f32x4){0.f, 0.f, 0.f, 0.f}; a2[1] = (f32x4){0.f, 0.f, 0.f, 0.f};
#pragma unroll
            for (int kb = 0; kb < 4; ++kb) {
                const bf16x8 a = *(const LAS bf16x8*)(Qt + (16 * tt + r16) * 136 + 32 * kb + 8 * quad);
#pragma unroll
                for (int j = 0; j < 2; ++j) { const bf16x8 bq = *(const LAS bf16x8*)(Kt + (16 * (st0 + j) + r16) * 136 + 32 * kb + 8 * quad); a2[j] = MFMA16(a, bq, a2[j]); }
            }
#pragma unroll
            for (int j = 0; j < 2; ++j)
#pragma unroll
                for (int e = 0; e < 4; ++e) { const int t = 16 * tt + 4 * quad + e, s = 16 * (st0 + j) + r16; As[t * 72 + s] = f2bf(s <= t ? a2[j][e] : 0.f); }
        }
        LDS_BARRIER();
        {
            const int tt = wave & 3, vt0 = 4 * (wave >> 2);
            f32x4 o4[4];
#pragma unroll
            for (int j = 0; j < 4; ++j) o4[j] = (f32x4){0.f, 0.f, 0.f, 0.f};
#pragma unroll
            for (int kb = 0; kb < 2; ++kb) {
                const bf16x8 a = *(const LAS bf16x8*)(As + (16 * tt + r16) * 72 + 32 * kb + 8 * quad);
#pragma unroll
                for (int j = 0; j < 4; ++j) { const bf16x8 bv = *(const LAS bf16x8*)(VT + (16 * (vt0 + j) + r16) * 72 + 32 * kb + 8 * quad); o4[j] = MFMA16(a, bv, o4[j]); }
            }
#pragma unroll
            for (int kb = 0; kb < 4; ++kb) {
                const bf16x8 a = *(const LAS bf16x8*)(Qh + (16 * tt + r16) * 136 + 32 * kb + 8 * quad);
#pragma unroll
                for (int j = 0; j < 4; ++j) { const bf16x8 bs = *(const LAS bf16x8*)(ST + (16 * (vt0 + j) + r16) * 136 + 32 * kb + 8 * quad); o4[j] = MFMA16(a, bs, o4[j]); }
            }
#pragma unroll
            for (int j = 0; j < 4; ++j)
#pragma unroll
                for (int e = 0; e < 4; ++e) Ob[(16 * tt + 4 * quad + e) * 132 + 16 * (vt0 + j) + r16] = o4[j][e];
        }
        {
            const f32x4 dec = *(const LAS f32x4*)(DEC + 16 * wave + 4 * quad);
#pragma unroll
            for (int vt = 0; vt < 8; ++vt) S[vt] = S[vt] * dec;
#pragma unroll
            for (int kb = 0; kb < 2; ++kb) {
                const bf16x8 a = *(const LAS bf16x8*)(KhT + (16 * wave + r16) * 72 + 32 * kb + 8 * quad);
#pragma unroll
                for (int vt = 0; vt < 8; ++vt) { const bf16x8 bv = *(const LAS bf16x8*)(VT + (16 * vt + r16) * 72 + 32 * kb + 8 * quad); S[vt] = MFMA16(a, bv, S[vt]); }
            }
        }
        LDS_BARRIER();
#pragma unroll
        for (int vt = 0; vt < 8; ++vt) { u32x2 w; w.x = pk2(S[vt][0], S[vt][1]); w.y = pk2(S[vt][2], S[vt][3]); *(LAS u32x2*)(ST + (16 * vt + r16) * 136 + 16 * wave + 4 * quad) = w; }
        {
            const int row = tid >> 3, sub = tid & 7;
            float ov[16], ss = 0.f;
#pragma unroll
            for (int k = 0; k < 16; ++k) { ov[k] = Ob[row * 132 + 16 * sub + k]; ss += ov[k] * ov[k]; }
            ss += __shfl_xor(ss, 1); ss += __shfl_xor(ss, 2); ss += __shfl_xor(ss, 4);
            const float rstd = __builtin_amdgcn_rsqf(ss * (1.f / 128.f) + RMS_EPS);
            const bf16_t* gp = PROJ + (size_t)(m0 + row) * NPROJ + C_HG + h * 128 + 16 * sub;
            const u32x4 g0 = *(const u32x4*)gp, g1 = *(const u32x4*)(gp + 8);
            const unsigned gw[8] = {g0.x, g0.y, g0.z, g0.w, g1.x, g1.y, g1.z, g1.w};
            unsigned w[8];
#pragma unroll
            for (int k = 0; k < 8; ++k) {
                const float ga = __uint_as_float(gw[k] << 16), gb = __uint_as_float(gw[k] & 0xffff0000u);
                const float ra = ov[2 * k] * rstd * gnorm[16 * sub + 2 * k] * (ga * __builtin_amdgcn_rcpf(1.f + __expf(-ga)));
                const float rb = ov[2 * k + 1] * rstd * gnorm[16 * sub + 2 * k + 1] * (gb * __builtin_amdgcn_rcpf(1.f + __expf(-gb)));
                w[k] = pk2(ra, rb);
            }
            bf16_t* dst = MIX + (size_t)(m0 + row) * DM + h * 128 + 16 * sub;
            *(u32x4*)dst = (u32x4){w[0], w[1], w[2], w[3]}; *(u32x4*)(dst + 8) = (u32x4){w[4], w[5], w[6], w[7]};
        }
        LDS_BARRIER();
    }
}

__device__ __forceinline__ void hgrn_item_naive(const Params& p, int l, int item, LAS unsigned char* lds, int tid, int wave, int lane) {
    const int b = item >> 2, h = item & 3;
    unsigned char* ws = p.ws; unsigned char* aux = (unsigned char*)p.out;
    const bf16_t* PROJ = (const bf16_t*)(ws + WS_PROJ);
    const float* LOGF = (const float*)(ws + WS_LOGF);
    bf16_t* MIX = (bf16_t*)(ws + WS_MIX);
    const float* gnorm = p.in[4] + l * 128;
    LAS float* Ob = (LAS float*)lds;
    LAS float* Fq = (LAS float*)(lds + 33792);
    LAS float* Ff = (LAS float*)(lds + 66560);
    LAS float* Pp = (LAS float*)(lds + 99328);
    const int v = tid & 127, dg = tid >> 7;
    float S[32];
#pragma unroll
    for (int i = 0; i < 32; ++i) S[i] = 0.f;
    for (int c = 0; c < 32; ++c) {
        const int m0 = b * T + c * 64;
        float vv[16];
        {
            const int d = tid & 127, seg = tid >> 7;
#pragma unroll
            for (int r = 0; r < 16; ++r) {
                const int row = seg * 16 + r;
                const bf16_t* pr = PROJ + (size_t)(m0 + row) * NPROJ + h * 128 + d;
                const float lf = LOGF[(size_t)(m0 + row) * 512 + h * 128 + d];
                const float q = bf2f(pr[C_HQ]);
                Fq[row * 128 + d] = q / (1.f + expf(-q));
                Ff[row * 128 + d] = expf(lf);
            }
        }
        __syncthreads();
        for (int t = 0; t < 64; ++t) {
            const float vt = bf2f(PROJ[(size_t)(m0 + t) * NPROJ + C_HI + h * 128 + v]);
            float part = 0.f;
#pragma unroll
            for (int i4 = 0; i4 < 8; ++i4) {
                const f32x4 f4 = *(const LAS f32x4*)(Ff + t * 128 + dg * 32 + 4 * i4);
                const f32x4 q4 = *(const LAS f32x4*)(Fq + t * 128 + dg * 32 + 4 * i4);
#pragma unroll
                for (int e = 0; e < 4; ++e) { const int i = 4 * i4 + e; S[i] = f4[e] * S[i] + (1.f - f4[e]) * vt; part += q4[e] * S[i]; }
            }
            Pp[(t & 1) * 512 + dg * 128 + v] = part;
            __syncthreads();
            if (dg == 0) Ob[t * 132 + v] = (Pp[(t & 1) * 512 + v] + Pp[(t & 1) * 512 + 128 + v]) + (Pp[(t & 1) * 512 + 256 + v] + Pp[(t & 1) * 512 + 384 + v]);
        }
        __syncthreads();
        {
            const int row = tid >> 3, sub = tid & 7;
            float ov[16], ss = 0.f;
#pragma unroll
            for (int k = 0; k < 16; ++k) { ov[k] = Ob[row * 132 + 16 * sub + k]; ss += ov[k] * ov[k]; }
            ss += __shfl_xor(ss, 1); ss += __shfl_xor(ss, 2); ss += __shfl_xor(ss, 4);
            const float rstd = 1.f / sqrtf(ss * (1.f / 128.f) + RMS_EPS);
            const bf16_t* gp = PROJ + (size_t)(m0 + row) * NPROJ + C_HG + h * 128 + 16 * sub;
            bf16_t* dst = MIX + (size_t)(m0 + row) * DM + h * 128 + 16 * sub;
#pragma unroll
            for (int k = 0; k < 16; ++k) { const float ga = bf2f(gp[k]); dst[k] = f2bf(ov[k] * rstd * gnorm[16 * sub + k] * (ga / (1.f + expf(-ga)))); }
        }
        __syncthreads();
    }
}
#define XB_TMO      128
#define XB_XCNT(j)  (256  + 64 * (j))
#define XB_XSUB(j)  (1280 + 64 * (j))
#define XB_XGEN(j)  (2304 + 64 * (j))
#define XB_TOP      3328
#define XB_TOPGEN   3392
#define XCD_BAR_WORDS 3456
#define XB_SPIN_CAP (1u << 18)

__device__ __forceinline__ unsigned xb_ld(unsigned* p)              { return __hip_atomic_load(p, __ATOMIC_RELAXED, __HIP_MEMORY_SCOPE_AGENT); }
__device__ __forceinline__ unsigned xb_add(unsigned* p, unsigned v) { return __hip_atomic_fetch_add(p, v, __ATOMIC_RELAXED, __HIP_MEMORY_SCOPE_AGENT); }
__device__ __forceinline__ unsigned xb_xcc_id() { return (unsigned)__builtin_amdgcn_s_getreg((3 << 11) | 20) & 0xFu; }
#define XB_SPIN(cond, bar) do { unsigned _sp = 0; while (cond) { __builtin_amdgcn_s_sleep(1); \
    if ((++_sp & 255u) == 0u) { if (xb_ld(&(bar)[XB_TMO])) break; if (_sp > XB_SPIN_CAP) { atomicAdd(&(bar)[XB_TMO], 1u); break; } } } } while (0)

struct XcdBarrier {
    unsigned* bar; unsigned x;
    volatile LAS unsigned* st;
};

__device__ __forceinline__ XcdBarrier xcd_barrier_post(unsigned* bar, volatile LAS unsigned* st) {
    XcdBarrier b; b.bar = bar; b.x = xb_xcc_id(); b.st = st;
    if (threadIdx.x == 0) (void)xb_add(&bar[XB_XCNT(b.x)], 1u);
    return b;
}
__device__ __forceinline__ void xcd_barrier_complete(unsigned* bar, unsigned x, unsigned& nloc, unsigned& nx) {
    const unsigned G = gridDim.x * gridDim.y * gridDim.z;
    unsigned sum, cnt, mine, sp = 0u;
    for (;;) {
        sum = 0u; cnt = 0u; mine = 0u;
#pragma unroll
        for (unsigned j = 0; j < 16; ++j) { const unsigned c = xb_ld(&bar[XB_XCNT(j)]); sum += c; cnt += (c > 0u) ? 1u : 0u; mine = (j == x) ? c : mine; }
        if (sum == G) break;
        __builtin_amdgcn_s_sleep(1);
        if ((++sp & 255u) == 0u) { if (xb_ld(&bar[XB_TMO])) break; if (sp > XB_SPIN_CAP) { atomicAdd(&bar[XB_TMO], 1u); break; } }
    }
    nloc = mine > 0u ? mine : 1u; nx = cnt > 0u ? cnt : 1u;
}

__device__ __forceinline__ void xcd_barrier(const XcdBarrier& b) {
    asm volatile("s_waitcnt vmcnt(0)" ::: "memory");
    __syncthreads();
    if (threadIdx.x == 0) {
        unsigned* bar = b.bar;
        __builtin_amdgcn_s_waitcnt(0);
        unsigned nloc = b.st[0], nx = b.st[1];
        if (nloc == 0u) { xcd_barrier_complete(bar, b.x, nloc, nx); b.st[0] = nloc; b.st[1] = nx; }
        const unsigned old = xb_add(&bar[XB_XSUB(b.x)], 1u);
        const unsigned gen = old / nloc;
        if (old + 1u == (gen + 1u) * nloc) {
            __builtin_amdgcn_fence(__ATOMIC_RELEASE, "agent");
            asm volatile("s_waitcnt vmcnt(0)" ::: "memory");
            const unsigned og = xb_add(&bar[XB_TOP], 1u);
            const unsigned tg = og / nx;
            if (og + 1u == (tg + 1u) * nx) xb_add(&bar[XB_TOPGEN], 1u);
            else XB_SPIN(xb_ld(&bar[XB_TOPGEN]) == tg, bar);
            __builtin_amdgcn_fence(__ATOMIC_ACQUIRE, "agent");
            xb_add(&bar[XB_XGEN(b.x)], 1u);
            asm volatile("s_waitcnt vmcnt(0)" ::: "memory");
        } else {
            XB_SPIN(xb_ld(&bar[XB_XGEN(b.x)]) == gen, bar);
            __builtin_amdgcn_fence(__ATOMIC_ACQUIRE, "agent");
            asm volatile("s_waitcnt vmcnt(0)" ::: "memory");
        }
    }
    __syncthreads();
}

template <int MODE>
__device__ __forceinline__ void attn_tile(const LAS bf16_t* Ks, const LAS bf16_t* Vs, const bf16x8 (&qf)[2][2], f32x4 (&o)[2][4], float (&lsum)[2], float m0,
                                          const int (&tk)[2], const unsigned (&selm)[2], int j, int quad, int r16, int mask_kind, int half, int pv) {
    if (pv == 1) return;
    Ks += half * 64 * 72; Vs += half * 64;
    bf16x8 kf[4][2];
#pragma unroll
    for (int kt = 0; kt < 4; ++kt)
#pragma unroll
        for (int kb = 0; kb < 2; ++kb) kf[kt][kb] = *(const LAS bf16x8*)(Ks + (16 * kt + r16) * 72 + 32 * kb + 8 * quad);
    __builtin_amdgcn_sched_barrier(0);
    const f32x4 cinit = (f32x4){-m0, -m0, -m0, -m0};
    f32x4 s[2][4];
#pragma unroll
    for (int kt = 0; kt < 4; ++kt) {
        s[0][kt] = MFMA16(kf[kt][0], qf[0][0], cinit); s[1][kt] = MFMA16(kf[kt][0], qf[1][0], cinit);
        s[0][kt] = MFMA16(kf[kt][1], qf[0][1], s[0][kt]); s[1][kt] = MFMA16(kf[kt][1], qf[1][1], s[1][kt]);
    }
    bf16x8 vf[4][2];
#pragma unroll
    for (int dt = 0; dt < 4; ++dt)
#pragma unroll
        for (int kb2 = 0; kb2 < 2; ++kb2) {
            const u32x2 v0 = *(const LAS u32x2*)(Vs + (16 * dt + r16) * 136 + 32 * kb2 + 4 * quad);
            const u32x2 v1 = *(const LAS u32x2*)(Vs + (16 * dt + r16) * 136 + 32 * kb2 + 16 + 4 * quad);
            vf[dt][kb2] = __builtin_bit_cast(bf16x8, ((u32x4){v0.x, v0.y, v1.x, v1.y}));
        }
    __builtin_amdgcn_sched_barrier(0);
    bf16x8 pf[2][2];
#pragma unroll
    for (int rt = 0; rt < 2; ++rt) {
#pragma unroll
        for (int kt = 0; kt < 4; ++kt)
#pragma unroll
            for (int e = 0; e < 4; ++e) s[rt][kt][e] = __builtin_amdgcn_exp2f(s[rt][kt][e]);
        const bool blk = (MODE == 1) ? (((selm[rt] >> j) & 1u) != 0u) : true;
        if (mask_kind == 2) {
            const int kbase = 64 * j + 4 * quad;
            const int hi = blk ? tk[rt] : -1;
            const int lo = (MODE == 2) ? tk[rt] - 512 : -1;
#pragma unroll
            for (int kt = 0; kt < 4; ++kt)
#pragma unroll
                for (int e = 0; e < 4; ++e) {
                    const int kpos = kbase + 16 * kt + e;
                    const bool v = (kpos <= hi) && (kpos > lo);
                    s[rt][kt][e] = v ? s[rt][kt][e] : 0.f;
                }
        }
        float rs = 0.f;
#pragma unroll
        for (int kt = 0; kt < 4; ++kt) rs += (s[rt][kt][0] + s[rt][kt][1]) + (s[rt][kt][2] + s[rt][kt][3]);
        const unsigned keep = (mask_kind == 1 && !blk) ? 0u : 0xffffffffu;
        if (mask_kind == 1) rs = blk ? rs : 0.f;
        lsum[rt] += rs;
#pragma unroll
        for (int kb2 = 0; kb2 < 2; ++kb2) {
            u32x4 w;
            w.x = pk2(s[rt][2 * kb2][0], s[rt][2 * kb2][1]); w.y = pk2(s[rt][2 * kb2][2], s[rt][2 * kb2][3]);
            w.z = pk2(s[rt][2 * kb2 + 1][0], s[rt][2 * kb2 + 1][1]); w.w = pk2(s[rt][2 * kb2 + 1][2], s[rt][2 * kb2 + 1][3]);
            if (mask_kind == 1) { w.x &= keep; w.y &= keep; w.z &= keep; w.w &= keep; }
            pf[rt][kb2] = __builtin_bit_cast(bf16x8, w);
        }
    }
#pragma unroll
    for (int dt = 0; dt < 4; ++dt)
#pragma unroll
        for (int kb2 = 0; kb2 < 2; ++kb2) { o[0][dt] = MFMA16(vf[dt][kb2], pf[0][kb2], o[0][dt]); o[1][dt] = MFMA16(vf[dt][kb2], pf[1][kb2], o[1][dt]); }
}

template <int MODE>
__device__ __forceinline__ void attn_branch(const bf16_t* Kb, const bf16_t* VTb, LAS bf16_t* Ks, LAS bf16_t* Vs, const bf16x8 (&qf)[2][2], LAS f32x4* outs,
                                            const float (&gsc)[2], const int (&tk)[2], const unsigned (&selm)[2], unsigned uni, bool sel_varies, int jlo, int jhi, int tid, int quad, int r16, float m0, int pv,
                                            u32x4& kA, u32x4& vA, u32x4& kB, u32x4& vB, bool preA, bool preB, const bf16_t* nKb, const bf16_t* nVTb, int nj0, int nj1) {
    f32x4 o[2][4];
#pragma unroll
    for (int rt = 0; rt < 2; ++rt)
#pragma unroll
        for (int dt = 0; dt < 4; ++dt) o[rt][dt] = (f32x4){0.f, 0.f, 0.f, 0.f};
    float lsum[2] = {0.f, 0.f};
    const int lr = tid >> 3, lc = (tid & 7) * 8;
#define NSA_NEXT(jv) do { ++(jv); } while ((jv) <= jhi && !((uni >> (jv)) & 1u))
#define NSA_LOAD(kr, vr, jv) do { kr = *(const u32x4*)(Kb + (size_t)(64 * (jv) + lr) * 64 + lc); vr = *(const u32x4*)(VTb + (size_t)(64 * (jv) + lr) * 64 + lc); } while (0)
#define NSA_KIND(jv) ((((jv) == jhi) || (MODE == 2 && (jv) + 8 <= jhi)) ? 2 : ((MODE == 1 && sel_varies) ? 1 : 0))
    int j0 = jlo - 1; NSA_NEXT(j0);
    int j1 = j0; NSA_NEXT(j1);
    if (j0 <= jhi && !preA) NSA_LOAD(kA, vA, j0);
    if (j1 <= jhi && !preB) NSA_LOAD(kB, vB, j1);
    while (j0 <= jhi) {
        int j2 = j1; NSA_NEXT(j2);
        int j3 = j2; NSA_NEXT(j3);
        LDS_BARRIER();
        *(LAS u32x4*)(Ks + lr * 72 + lc) = kA; *(LAS u32x4*)(Vs + lr * 136 + lc) = vA;
        *(LAS u32x4*)(Ks + (64 + lr) * 72 + lc) = kB; *(LAS u32x4*)(Vs + lr * 136 + 64 + lc) = vB;
        if (j2 <= jhi) { NSA_LOAD(kA, vA, j2); if (j3 <= jhi) NSA_LOAD(kB, vB, j3); }
        else if (nKb) {
            kA = *(const u32x4*)(nKb + (size_t)(64 * nj0 + lr) * 64 + lc); vA = *(const u32x4*)(nVTb + (size_t)(64 * nj0 + lr) * 64 + lc);
            if (nj1 >= 0) { kB = *(const u32x4*)(nKb + (size_t)(64 * nj1 + lr) * 64 + lc); vB = *(const u32x4*)(nVTb + (size_t)(64 * nj1 + lr) * 64 + lc); }
        }
        LDS_BARRIER();
        attn_tile<MODE>(Ks, Vs, qf, o, lsum, m0, tk, selm, j0, quad, r16, NSA_KIND(j0), 0, pv);
        if (j1 <= jhi) attn_tile<MODE>(Ks, Vs, qf, o, lsum, m0, tk, selm, j1, quad, r16, NSA_KIND(j1), 1, pv);
        j0 = j2; j1 = j3;
    }
#undef NSA_KIND
#undef NSA_NEXT
#undef NSA_LOAD
#pragma unroll
    for (int rt = 0; rt < 2; ++rt) {
        float lr_ = lsum[rt]; lr_ += __shfl_xor(lr_, 16); lr_ += __shfl_xor(lr_, 32);
        const float inv = lr_ > 0.f ? gsc[rt] / lr_ : 0.f;
#pragma unroll
        for (int dt = 0; dt < 4; ++dt) outs[(rt * 4 + dt) * 64] = outs[(rt * 4 + dt) * 64] + o[rt][dt] * inv;
    }
}

__device__ __forceinline__ void nsa_unit(const Params& p, int l, int item, LAS unsigned char* lds, int tid, int wave, int lane, int pv) {
    const int qt = 31 - (item & 31), bg = item >> 5, b = bg >> 1, g = bg & 1, t0 = qt * 64;
    const int quad = lane >> 4, r16 = lane & 15, hh = lane & 3;
    unsigned char* ws = p.ws; unsigned char* aux = (unsigned char*)p.out;
    const bf16_t* PROJ = (const bf16_t*)(ws + WS_PROJ);
    LAS bf16_t* Ks = (LAS bf16_t*)lds;
    LAS bf16_t* Vs = (LAS bf16_t*)(lds + 18432);
    LAS float* IMP = (LAS float*)(lds + 35840);
    LAS unsigned* SEL = (LAS unsigned*)(lds + 44288);
    int tk[2]; tk[0] = t0 + 8 * wave + (r16 >> 2); tk[1] = tk[0] + 4;
    bf16x8 qf[2][2];
    {
        const bf16_t* Qb = (const bf16_t*)(ws + WS_QN) + ((size_t)bg * T + t0) * 256;
#pragma unroll
        for (int rt = 0; rt < 2; ++rt)
#pragma unroll
            for (int kb = 0; kb < 2; ++kb) qf[rt][kb] = *(const bf16x8*)(Qb + (size_t)(32 * wave + 16 * rt + r16) * 64 + 32 * kb + 8 * quad);
    }
    float gt[3][2];
#pragma unroll
    for (int rt = 0; rt < 2; ++rt)
#pragma unroll
        for (int br = 0; br < 3; ++br) { const float z = bf2f(PROJ[(size_t)(b * T + tk[rt]) * NPROJ + C_GT + (g * 4 + hh) * 3 + br]); gt[br][rt] = 1.f / (1.f + __expf(-z)); }
    const float* M0T = (const float*)(ws + WS_CTL + 24576) + 4 * l;
    const float m0c = M0T[0], m0s = M0T[1], m0w = M0T[2];
    f32x4 out[2][4];
#pragma unroll
    for (int rt = 0; rt < 2; ++rt)
#pragma unroll
        for (int dt = 0; dt < 4; ++dt) out[rt][dt] = (f32x4){0.f, 0.f, 0.f, 0.f};
    const bf16_t* KSb = (const bf16_t*)(aux + AX_KS) + (size_t)bg * T * 64; const bf16_t* VSTb = (const bf16_t*)(aux + AX_VST) + (size_t)bg * 64 * T;
    const bf16_t* KWb = (const bf16_t*)(aux + AX_KW) + (size_t)bg * T * 64; const bf16_t* VWTb = (const bf16_t*)(aux + AX_VWT) + (size_t)bg * 64 * T;
    u32x4 kA, vA, kB = (u32x4){0u, 0u, 0u, 0u}, vB = kB;
    kA = *(const u32x4*)(KSb + (size_t)(tid >> 3) * 64 + (tid & 7) * 8); vA = *(const u32x4*)(VSTb + (size_t)(tid >> 3) * 64 + (tid & 7) * 8);
    {
        const bf16_t* KCb = (const bf16_t*)(aux + AX_KC) + (size_t)bg * 128 * 64;
        const bf16_t* VCb = (const bf16_t*)(aux + AX_VCT) + (size_t)bg * 64 * 128;
#pragma unroll
        for (int k = 0; k < 2; ++k) {
            const int c = tid + 512 * k;
            *(LAS u32x4*)(Ks + (c >> 3) * 72 + (c & 7) * 8) = *(const u32x4*)(KCb + (size_t)(c >> 3) * 64 + (c & 7) * 8);
            *(LAS u32x4*)(Vs + (c >> 4) * 136 + (c & 15) * 8) = *(const u32x4*)(VCb + (size_t)(c >> 4) * 128 + (c & 15) * 8);
        }
        __syncthreads();
        const int ktmax = (4 * qt + 2) >> 4;
#pragma unroll
        for (int rt = 0; rt < 2; ++rt) {
            f32x4 s[8];
#pragma unroll
            for (int kt = 0; kt < 8; ++kt) {
                s[kt] = (f32x4){0.f, 0.f, 0.f, 0.f};
                {
#pragma unroll
                    for (int kb = 0; kb < 2; ++kb) { const bf16x8 a = *(const LAS bf16x8*)(Ks + (16 * kt + r16) * 72 + 32 * kb + 8 * quad); s[kt] = MFMA16(a, qf[rt][kb], s[kt]); }
                }
            }
            float rs = 0.f;
#pragma unroll
            for (int kt = 0; kt < 8; ++kt) {
                {
#pragma unroll
                    for (int e = 0; e < 4; ++e) { const int n = 16 * kt + 4 * quad + e; const bool v = (16 * n + 31 <= tk[rt]); const float pv = v ? __builtin_amdgcn_exp2f(s[kt][e] - m0c) : 0.f; s[kt][e] = pv; rs += pv; }
                }
            }
            rs += __shfl_xor(rs, 16); rs += __shfl_xor(rs, 32);
            const float inv = rs > 0.f ? 1.f / rs : 0.f;
#pragma unroll
            for (int kt = 0; kt < 8; ++kt) s[kt] = s[kt] * inv;
            if (qt >= 16) {
                float sh[8];
#pragma unroll
                for (int kt = 0; kt < 8; ++kt) sh[kt] = __shfl(s[kt][3], (lane + 48) & 63);
#pragma unroll
                for (int kt = 0; kt < 8; ++kt) {
                    const float nb = quad ? sh[kt] : (kt ? sh[kt > 0 ? kt - 1 : 0] : 0.f);
                    float im = (s[kt][0] + s[kt][1]) + (s[kt][2] + s[kt][3]) + nb;
                    im += __shfl_xor(im, 1); im += __shfl_xor(im, 2);
                    if (hh == 0) IMP[(8 * wave + 4 * rt + (r16 >> 2)) * 33 + 4 * kt + quad] = im;
                }
            }
            const float gs = gt[0][rt];
#pragma unroll
            for (int dt = 0; dt < 4; ++dt) {
                f32x4 oc = (f32x4){0.f, 0.f, 0.f, 0.f};
#pragma unroll
                for (int kb2 = 0; kb2 < 4; ++kb2) {
                    u32x4 w;
                    w.x = pk2(s[2 * kb2][0], s[2 * kb2][1]); w.y = pk2(s[2 * kb2][2], s[2 * kb2][3]);
                    w.z = pk2(s[2 * kb2 + 1][0], s[2 * kb2 + 1][1]); w.w = pk2(s[2 * kb2 + 1][2], s[2 * kb2 + 1][3]);
                    const bf16x8 pfr = __builtin_bit_cast(bf16x8, w);
                    const u32x2 v0 = *(const LAS u32x2*)(Vs + (16 * dt + r16) * 136 + 32 * kb2 + 4 * quad);
                    const u32x2 v1 = *(const LAS u32x2*)(Vs + (16 * dt + r16) * 136 + 32 * kb2 + 16 + 4 * quad);
                    const bf16x8 vf = __builtin_bit_cast(bf16x8, ((u32x4){v0.x, v0.y, v1.x, v1.y}));
                    oc = MFMA16(vf, pfr, oc);
                }
                out[rt][dt] = out[rt][dt] + oc * gs;
            }
            asm volatile("" ::: "memory");
        }
    }
    LAS f32x4* outs = (LAS f32x4*)(lds + 49152) + wave * 512 + lane;
#pragma unroll
    for (int rt = 0; rt < 2; ++rt)
#pragma unroll
        for (int dt = 0; dt < 4; ++dt) outs[(rt * 4 + dt) * 64] = out[rt][dt];
    unsigned selm[2], uni;
    if (qt >= 16) {
        __syncthreads();
#pragma unroll
        for (int ps = 0; ps < 4; ++ps) {
            const int token = 16 * ps + (tid >> 5), j = tid & 31;
            const float my = IMP[token * 33 + j];
            int rank = 0;
            for (int jj = 1; jj <= qt - 2; ++jj) { const float ov = IMP[token * 33 + jj]; rank += ((ov > my) || (ov == my && jj < j)) ? 1 : 0; }
            const bool sel = (j == 0) || (j == qt) || (j == qt - 1) || (j >= 1 && j <= qt - 2 && rank < 13);
            const unsigned long long bal = __ballot(sel);
            if ((lane & 31) == 0) SEL[token] = (lane < 32) ? (unsigned)bal : (unsigned)(bal >> 32);
        }
        __syncthreads();
        selm[0] = SEL[8 * wave + (r16 >> 2)]; selm[1] = SEL[8 * wave + 4 + (r16 >> 2)];
        uni = 0u;
        for (int k = 0; k < 64; ++k) uni |= SEL[k];
        uni = __builtin_amdgcn_readfirstlane(uni);
    } else { selm[0] = selm[1] = uni = (2u << qt) - 1u; }
    {
        const int wlo = qt > 8 ? qt - 8 : 0;
        {
            const float gsc[2] = {gt[1][0], gt[1][1]};
            attn_branch<1>(KSb, VSTb, Ks, Vs, qf, outs, gsc, tk, selm, uni, qt >= 16, 0, qt, tid, quad, r16, m0s, pv,
                           kA, vA, kB, vB, true, false, KWb, VWTb, wlo, wlo + 1 <= qt ? wlo + 1 : -1);
        }
        {
            const float gsc[2] = {gt[2][0], gt[2][1]};
            attn_branch<2>(KWb, VWTb, Ks, Vs, qf, outs, gsc, tk, selm, 0xffffffffu, false, wlo, qt, tid, quad, r16, m0w, pv,
                           kA, vA, kB, vB, true, true, (const bf16_t*)nullptr, (const bf16_t*)nullptr, 0, -1);
        }
    }
    {
        bf16_t* MIX = (bf16_t*)(ws + WS_MIX);
#pragma unroll
        for (int rt = 0; rt < 2; ++rt)
#pragma unroll
            for (int dt = 0; dt < 4; ++dt) {
                const f32x4 ov = outs[(rt * 4 + dt) * 64];
                u32x2 w; w.x = pk2(ov[0], ov[1]); w.y = pk2(ov[2], ov[3]);
                if (NSA_ZERO) { w.x = 0u; w.y = 0u; }
                *(u32x2*)(MIX + (size_t)(b * T + tk[rt]) * DM + 512 + (g * 4 + hh) * 64 + 16 * dt + 4 * quad) = w;
            }
    }
    LDS_BARRIER();
}

#ifndef NSA_PV
#define NSA_PV 0
#endif
#ifndef PROBE_NSA2
#define PROBE_NSA2 0
#endif
#ifndef STAGGER_US
#define STAGGER_US 0
#endif
#ifndef PROBE_HG2
#define PROBE_HG2 0
#endif
#ifndef PROBE_DUP
#define PROBE_DUP 0
#endif
#ifndef NAIVE_MASK
#define NAIVE_MASK 0
#endif
#ifndef HG_NAIVE
#define HG_NAIVE 0
#endif
#ifndef PHMASK
#define PHMASK 0x1ff
#endif
constexpr int N_PHASES = 1 + 8 * DEPTH;
__global__ void __launch_bounds__(NTHREADS) fwd_kernel(Params p) {
    extern __shared__ __attribute__((aligned(16))) unsigned char lds_raw[];
    LAS unsigned char* lds = (LAS unsigned char*)lds_raw;
    const int G = gridDim.x, NGW = G * 8;
    unsigned char* ws = p.ws;
    if (threadIdx.x < 2) ((LAS unsigned*)(lds + LDS_BYTES - 32))[threadIdx.x] = 0u;
    __syncthreads();
    const XcdBarrier xbar = xcd_barrier_post((unsigned*)(ws + WS_XBAR), (volatile LAS unsigned*)(lds + LDS_BYTES - 32));
    for (int ph = p.ph_lo; ph < p.ph_hi; ++ph) {
        if (ph > p.ph_lo) {
            if (p.ph_hi < 0) cg::this_grid().sync();
            xcd_barrier(xbar);
        }
        const int code = p.prog[ph], l = code >> 4, sub = code & 15;
        int tid = threadIdx.x; asm volatile("" : "+v"(tid));
        int bid = blockIdx.x; asm volatile("" : "+s"(bid));
        const int lane = tid & 63, wave = __builtin_amdgcn_readfirstlane(tid >> 6), gw = bid * 8 + wave;
        if (sub == 8) { prologue_phase(p, lds, gw, NGW, wave, lane); continue; }
        if (sub == 0 && (PHMASK & 2)) {
            pg8::Gemm g{(const bf16_t*)(ws + WS_XN), (const bf16_t*)(ws + WS_WIN) + (size_t)l * NPROJ * DM, M, NPROJ, DM};
            pg8::StaticOrder S; S.init(M, NPROJ, G, bid);
            EpiProj E{(bf16_t*)(ws + WS_PROJ), (float*)(ws + WS_LOGF), (const float*)(ws + WS_CTL + 16384) + l * 512, (const float*)(ws + WS_RS) + (size_t)(2 * l) * M};
            pg8::gemm_phase<EpiProj, pg8::StaticOrder, true, true>(lds, g, S, E, tid);
        } else if (sub == 1 && (PHMASK & 4)) {
            for (int it = bid; it < 256 + 1024; it += G) {
                int t2 = tid; asm volatile("" : "+v"(t2));
                const int l2 = t2 & 63, w2 = __builtin_amdgcn_readfirstlane(t2 >> 6);
                if (it < 256) compress_item(p, l, it, lds, t2, w2, l2);
                else prep_item(p, l, it - 256, lds, t2, w2, l2);
            }
        } else if ((sub == 2 || sub == 9) && (PHMASK & 8)) {
            unsigned* qc = (unsigned*)(ws + WS_QCTR) + (size_t)ph * 8 * 64;
            const unsigned xcc = (unsigned)__builtin_amdgcn_s_getreg((3 << 11) | 20) & 7u;
            LAS int* qslot = (LAS int*)(lds + LDS_BYTES - 16);
#define Q_POP(dst) do { int it_ = 1 << 30; \
                for (unsigned k_ = 0; k_ < 8u; ++k_) { const unsigned x_ = (xcc + k_) & 7u; unsigned* c_ = qc + 64 * x_; \
                    if (__hip_atomic_load(c_, __ATOMIC_RELAXED, __HIP_MEMORY_SCOPE_AGENT) >= 272u) continue; \
                    const unsigned i_ = atomicAdd(c_, 1u); if (i_ >= 272u) continue; \
                    it_ = (i_ < 16u) ? (int)(x_ * 16u + i_) : 128 + (int)((x_ + 8u * ((i_ - 16u) >> 5)) * 32u + ((i_ - 16u) & 31u)); break; } \
                dst = it_; } while (0)
            if (tid == 0) { int it0; Q_POP(it0); *qslot = it0; }
            __syncthreads();
            for (;;) {
                const int item = __builtin_amdgcn_readfirstlane(*qslot);
                LDS_BARRIER();
                if (item >= 128 + 2048) break;
                int nxt = 0;
                if (tid == 0) Q_POP(nxt);
                int t2 = tid; asm volatile("" : "+v"(t2));
                const int l2 = t2 & 63, w2 = __builtin_amdgcn_readfirstlane(t2 >> 6);
                if (item < 128) hgrn_item(p, l, item, lds, t2, w2, l2);
                else nsa_unit(p, l, item - 128, lds, t2, w2, l2, 0);
                if (tid == 0) *qslot = nxt;
                LDS_BARRIER();
            }
#undef Q_POP
        } else if ((sub == 3 || sub == 6) && (PHMASK & 16)) {
            const bool ffn = (sub == 6);
            pg8::Gemm g{ffn ? (const bf16_t*)(ws + WS_PROJ) : (const bf16_t*)(ws + WS_MIX),
                        ffn ? (const bf16_t*)(ws + WS_WFFO) + (size_t)l * DM * DFF : (const bf16_t*)(ws + WS_WOUT) + (size_t)l * DM * DM, M, DM, ffn ? DFF : DM};
            pg8::StaticOrder S; S.init(M, DM, G, bid);
            const bool last = ffn && (l + 1 == DEPTH);
            EpiRes E{(bf16_t*)(ws + WS_XN), last ? p.out : (float*)nullptr, (float*)(ws + WS_RS) + (size_t)(2 * l + (ffn ? 2 : 1)) * M};
            if (STAGGER_US && (bid & 8)) { const unsigned long long t0 = __builtin_amdgcn_s_memrealtime(); while (__builtin_amdgcn_s_memrealtime() - t0 < (unsigned long long)(STAGGER_US * 100)) __builtin_amdgcn_s_sleep(32); }
            pg8::gemm_phase<EpiRes, pg8::StaticOrder, true, true>(lds, g, S, E, tid);
        } else if (sub == 5 && (PHMASK & 64)) {
            pg8::Gemm g{(const bf16_t*)(ws + WS_XN), (const bf16_t*)(ws + WS_WFFI) + (size_t)l * 2 * DFF * DM, M, 2 * DFF, DM};
            pg8::StaticOrder S; S.init(M, 2 * DFF, G, bid);
            EpiSwiGLU E{(bf16_t*)(ws + WS_PROJ), (const float*)(ws + WS_RS) + (size_t)(2 * l + 1) * M};
            pg8::gemm_phase<EpiSwiGLU, pg8::StaticOrder, true, true>(lds, g, S, E, tid);
        }
    }
}

#ifndef MK_COOP
#define MK_COOP 1
#endif
extern "C" void kernel_launch(void* const* d_in, const int* in_sizes, int n_in, void* d_out, int out_size, void* d_ws, size_t ws_size, hipStream_t stream) {
    static int grid = 0;
    if (grid == 0) {
        if (n_in != 17 || out_size != M * DM || ws_size < WS_END) { fprintf(stderr, "kernel_launch: unexpected shapes (n_in %d out %d ws %zu)\n", n_in, out_size, ws_size); grid = -1; return; }
        int dev = 0, cus = 0, per_cu = 0;
        (void)hipGetDevice(&dev); (void)hipDeviceGetAttribute(&cus, hipDeviceAttributeMultiprocessorCount, dev);
        if (hipFuncSetAttribute((const void*)fwd_kernel, hipFuncAttributeMaxDynamicSharedMemorySize, LDS_BYTES) != hipSuccess) { fprintf(stderr, "kernel_launch: hipFuncSetAttribute failed\n"); grid = -1; return; }
        if (hipOccupancyMaxActiveBlocksPerMultiprocessor(&per_cu, (const void*)fwd_kernel, NTHREADS, LDS_BYTES) != hipSuccess || per_cu < 1) { fprintf(stderr, "kernel_launch: occupancy query says %d\n", per_cu); per_cu = 1; }
        (void)hipGetLastError();
        grid = cus > 0 ? cus : 256;
    }
    if (grid < 0) return;
    if (hipMemsetAsync((char*)d_ws + WS_XBAR, 0, 3456 * sizeof(unsigned), stream) != hipSuccess) { fprintf(stderr, "kernel_launch: hipMemsetAsync of the barrier words failed\n"); return; }
    Params p{};
    for (int i = 0; i < 17; ++i) p.in[i] = (const float*)d_in[i];
    p.out = (float*)d_out; p.ws = (unsigned char*)d_ws;
    int np = 0;
    auto add = [&](int l, int sub, int dupbit) { p.prog[np++] = (unsigned char)((l << 4) | sub); if (PROBE_DUP & dupbit) p.prog[np++] = (unsigned char)((l << 4) | sub); };
    add(0, 8, 1);
    for (int l = 0; l < DEPTH; ++l) { add(l, 0, 0); add(l, 1, 2); if (PROBE_NSA2) add(l, 9, 0); add(l, 2, 4); add(l, 3, 0); add(l, 5, 0); add(l, 6, 0); }
    const int N_PH = np;
#if MK_COOP
    p.ph_lo = 0; p.ph_hi = N_PH;
    void* args[] = {&p};
    hipError_t e = hipLaunchCooperativeKernel((const void*)fwd_kernel, dim3(grid), dim3(NTHREADS), args, LDS_BYTES, stream);
    if (e != hipSuccess) fprintf(stderr, "cooperative launch failed: %s (grid %d)\n", hipGetErrorString(e), grid);
#else
    for (int ph = 0; ph < N_PH; ++ph) {
        p.ph_lo = ph; p.ph_hi = ph + 1;
        hipLaunchKernelGGL(fwd_kernel, dim3(grid), dim3(NTHREADS), LDS_BYTES, stream, p);
    }
#endif
}
```

```cpp
#include <hip/hip_runtime.h>
#include <hip/hip_cooperative_groups.h>
#include <cstdio>
#include <cstdint>
namespace cg = cooperative_groups;
namespace pg8 {
#define PG8_LAS __attribute__((address_space(3)))
typedef unsigned short bf16_t;
typedef short bf16x8 __attribute__((ext_vector_type(8)));
typedef float f32x4 __attribute__((ext_vector_type(4)));
typedef unsigned u32x4 __attribute__((ext_vector_type(4)));
constexpr int BM = 256, BK = 64, HALF = 128, HTB = HALF * BK * 2  , STAGE_BYTES = 8 * HTB, NXCD = 8, WGM = 8;

__host__ __device__ __forceinline__ int lds_byte(int r, int c) { const int st = (r >> 4) * 2 + (c >> 5), rr = r & 15, cc = c & 31, ob = rr * 64 + cc * 2; return st * 1024 + (ob ^ (((ob >> 9) & 1) << 5)); }
__host__ __device__ __forceinline__ void stage_rc(int b, int& R, int& C) { const int st = b / 1024, sb = b % 1024, swz = sb ^ (((sb >> 9) & 1) << 5); R = (st >> 1) * 16 + swz / 64; C = (st & 1) * 32 + (swz % 64) / 2; }
__host__ __device__ __forceinline__ int perm32(int rho) { const int n = rho >> 4, i = rho & 15; return 8 * (i >> 2) + 4 * n + (i & 3); }

struct Unit { int pm, pn; };
struct Gemm { const bf16_t* A; const bf16_t* Bt; int M, N, K; };

struct StaticOrder {
    int nM, nN, nwg, G, c;
    __host__ __device__ void init(int M, int N, int G_, int c_) { nM = M / BM; nN = N / BM; nwg = nM * nN; G = G_; c = c_; }
    __host__ __device__ bool next(int i, Unit& u) const {
        const long L = (long)i * G + c; if (L >= nwg) return false;
        int wgid = (int)L; { const int q = nwg / NXCD, r = nwg % NXCD, xcd = wgid % NXCD, off = wgid / NXCD; wgid = (xcd < r ? xcd * (q + 1) : r * (q + 1) + (xcd - r) * q) + off; }
        const int nig = WGM * nN, gid = wgid / nig, fm = gid * WGM, gsz = (nM - fm) < WGM ? (nM - fm) : WGM;
        u.pm = fm + ((wgid % nig) % gsz); u.pn = (wgid % nig) / gsz; return true;
    }
    __device__ __forceinline__ void a_ready(const Unit&) const {}
    __device__ __forceinline__ void done(const Unit&) const {}
};

__device__ __forceinline__ unsigned cvt_pk_bf16(float lo, float hi) { unsigned r; asm volatile("v_cvt_pk_bf16_f32 %0, %1, %2" : "=v"(r) : "v"(lo), "v"(hi)); return r; }
typedef float f32x2 __attribute__((ext_vector_type(2)));
template <class Epi, class Sched, bool ALIGN_EPI = false, bool SP2 = false>
__device__ __forceinline__ void gemm_phase(PG8_LAS unsigned char* lds, const Gemm g, const Sched& S, const Epi& E, const int tid) {
    const int wid = __builtin_amdgcn_readfirstlane(tid >> 6), lane = tid & 63, wr = wid >> 2, wc = wid & 3, fr = lane & 15, fq = lane >> 4;
    const int K = g.K, nt = K / BK;
    unsigned voffA[2], voffB[2];
#pragma unroll
    for (int i = 0; i < 2; ++i) { int R, C; stage_rc(tid * 16 + i * 8192, R, C); const int Rb = Epi::PERM ? ((R & ~31) + perm32(R & 31)) : R;
        voffA[i] = (unsigned)(R * K + C) * 2u; voffB[i] = (unsigned)(Rb * K + C) * 2u; }
    const size_t kstep = (size_t)(BK * 2);
    const size_t hstep = (size_t)HALF * K * 2;
    const size_t tstep = 2 * hstep;
    const unsigned ldsw = (unsigned)wid * 1024u;
    const int aoff = lds_byte(wr * 64 + fr, fq * 8), boff = lds_byte(wc * 32 + fr, fq * 8);
#define PG8_SA(b, h) (((b) * 2 + (h)) * HTB)
#define PG8_SB(b, h) ((4 + (b) * 2 + (h)) * HTB)
#define PG8_STAGE(bufoff, gbase, voff) do { _Pragma("unroll") for (int _i = 0; _i < 2; ++_i) \
        __builtin_amdgcn_global_load_lds((const unsigned*)((const char*)(gbase) + (voff)[_i]), (PG8_LAS unsigned*)(lds + (bufoff) + ldsw + _i * 8192), 16, 0, 0); } while (0)
#define PG8_LDA(dst, b, h) do { _Pragma("unroll") for (int m = 0; m < 4; ++m) _Pragma("unroll") for (int k = 0; k < 2; ++k) dst[m][k] = *(const PG8_LAS bf16x8*)(lds + PG8_SA(b, h) + aoff + m * 2048 + k * 1024); } while (0)
#define PG8_LDB(dst, b, h) do { _Pragma("unroll") for (int n = 0; n < 2; ++n) _Pragma("unroll") for (int k = 0; k < 2; ++k) dst[n][k] = *(const PG8_LAS bf16x8*)(lds + PG8_SB(b, h) + boff + n * 2048 + k * 1024); } while (0)
#define PG8_MMA(ai, bj, At, Bt) do { __builtin_amdgcn_s_setprio(1); _Pragma("unroll") for (int m = 0; m < 4; ++m) _Pragma("unroll") for (int n = 0; n < 2; ++n) _Pragma("unroll") for (int k = 0; k < 2; ++k) \
        acc[ai][bj][m][n] = __builtin_amdgcn_mfma_f32_16x16x32_bf16(Bt[n][k], At[m][k], acc[ai][bj][m][n], 0, 0, 0); __builtin_amdgcn_s_setprio(0); } while (0)
#define PG8_WAIT_V(n) asm volatile("s_waitcnt vmcnt(" #n ")" ::: "memory")
#define PG8_WAIT_L(n) asm volatile("s_waitcnt lgkmcnt(" #n ")" ::: "memory")
#define PG8_BAR __builtin_amdgcn_s_barrier()
#define PG8_SCHED __builtin_amdgcn_sched_barrier(0)
    Unit cur, nxt; int ui = 0;
    if (!S.next(0, cur)) return;
    f32x4 acc[2][2][4][2];
#pragma unroll
    for (int a = 0; a < 2; ++a)
#pragma unroll
        for (int b = 0; b < 2; ++b)
#pragma unroll
            for (int m = 0; m < 4; ++m)
#pragma unroll
                for (int n = 0; n < 2; ++n) acc[a][b][m][n] = (f32x4){0.f, 0.f, 0.f, 0.f};
    bf16x8 At[4][2], B0[2][2], B1[2][2];
    const char* cA = (const char*)g.A + (size_t)cur.pm * tstep; const char* cB = (const char*)g.Bt + (size_t)cur.pn * tstep;
    S.a_ready(cur);
    if constexpr (SP2) {
        PG8_STAGE(PG8_SB(0, 0), cB, voffB); PG8_STAGE(PG8_SB(0, 1), cB + hstep, voffB); PG8_STAGE(PG8_SA(0, 0), cA, voffA); PG8_STAGE(PG8_SA(0, 1), cA + hstep, voffA);
        if (wr == 1) PG8_BAR;
        PG8_WAIT_V(2); PG8_BAR;
        PG8_STAGE(PG8_SB(1, 0), cB + kstep, voffB); PG8_STAGE(PG8_SA(1, 0), cA + kstep, voffA); PG8_STAGE(PG8_SB(1, 1), cB + hstep + kstep, voffB);
        PG8_WAIT_V(6); PG8_BAR;
    } else {
        PG8_STAGE(PG8_SB(0, 0), cB, voffB); PG8_STAGE(PG8_SA(0, 0), cA, voffA); PG8_STAGE(PG8_SB(0, 1), cB + hstep, voffB); PG8_STAGE(PG8_SA(0, 1), cA + hstep, voffA);
        if (wr == 1) PG8_BAR;
        PG8_WAIT_V(4); PG8_BAR;
        PG8_STAGE(PG8_SB(1, 0), cB + kstep, voffB); PG8_STAGE(PG8_SA(1, 0), cA + kstep, voffA); PG8_STAGE(PG8_SB(1, 1), cB + hstep + kstep, voffB);
        PG8_WAIT_V(6); PG8_BAR;
    }
    for (;;) {
        const bool has_next = S.next(ui + 1, nxt);
        const char* nA = has_next ? (const char*)g.A + (size_t)nxt.pm * tstep : cA; const char* nB = has_next ? (const char*)g.Bt + (size_t)nxt.pn * tstep : cB;
        for (int t = 0; t < nt; t += 2) {
            const bool last = (t == nt - 2);
            const char* a1 = cA + (size_t)(t + 1) * kstep;
            const char* a2 = last ? nA : cA + (size_t)(t + 2) * kstep; const char* b2 = last ? nB : cB + (size_t)(t + 2) * kstep;
            const char* a3 = a2 + kstep; const char* b3 = b2 + kstep;
            if (last && has_next) S.a_ready(nxt);
            if constexpr (SP2) {
            PG8_LDB(B0, 0, 0); PG8_LDB(B1, 0, 1); PG8_SCHED; PG8_LDA(At, 0, 0); PG8_STAGE(PG8_SA(1, 1), a1 + hstep, voffA);
            PG8_WAIT_V(8); PG8_WAIT_L(0); PG8_BAR; PG8_MMA(0, 0, At, B0); PG8_MMA(0, 1, At, B1); PG8_BAR; PG8_SCHED;
            PG8_LDA(At, 0, 1); PG8_STAGE(PG8_SB(0, 0), b2, voffB); PG8_STAGE(PG8_SB(0, 1), b2 + hstep, voffB); PG8_STAGE(PG8_SA(0, 0), a2, voffA);
            PG8_WAIT_V(8); PG8_WAIT_L(0); PG8_BAR; PG8_MMA(1, 0, At, B0); PG8_MMA(1, 1, At, B1); PG8_BAR; PG8_SCHED;
            PG8_LDB(B0, 1, 0); PG8_LDB(B1, 1, 1); PG8_SCHED; PG8_LDA(At, 1, 0); PG8_STAGE(PG8_SA(0, 1), a2 + hstep, voffA);
            PG8_WAIT_V(8); PG8_WAIT_L(0); PG8_BAR; PG8_MMA(0, 0, At, B0); PG8_MMA(0, 1, At, B1); PG8_BAR; PG8_SCHED;
            PG8_LDA(At, 1, 1); PG8_STAGE(PG8_SB(1, 0), b3, voffB); PG8_STAGE(PG8_SB(1, 1), b3 + hstep, voffB); PG8_STAGE(PG8_SA(1, 0), a3, voffA);
            PG8_WAIT_V(8); PG8_WAIT_L(0); PG8_BAR; PG8_MMA(1, 0, At, B0); PG8_MMA(1, 1, At, B1); PG8_BAR; PG8_SCHED;
            } else {
            PG8_LDB(B0, 0, 0); PG8_SCHED; PG8_LDA(At, 0, 0); PG8_STAGE(PG8_SA(1, 1), a1 + hstep, voffA);
            PG8_WAIT_L(8); PG8_BAR; PG8_WAIT_L(0); PG8_MMA(0, 0, At, B0); PG8_BAR; PG8_SCHED;
            PG8_LDB(B1, 0, 1); PG8_STAGE(PG8_SB(0, 0), b2, voffB);
            PG8_BAR; PG8_WAIT_L(0); PG8_MMA(0, 1, At, B1); PG8_BAR;
            PG8_LDA(At, 0, 1); PG8_STAGE(PG8_SA(0, 0), a2, voffA);
            PG8_BAR; PG8_WAIT_L(0); PG8_MMA(1, 0, At, B0); PG8_BAR; PG8_SCHED;
            PG8_STAGE(PG8_SB(0, 1), b2 + hstep, voffB);
            PG8_WAIT_V(6); PG8_BAR; PG8_MMA(1, 1, At, B1); PG8_BAR;
            PG8_LDB(B0, 1, 0); PG8_SCHED; PG8_LDA(At, 1, 0); PG8_STAGE(PG8_SA(0, 1), a2 + hstep, voffA);
            PG8_WAIT_L(8); PG8_BAR; PG8_WAIT_L(0); PG8_MMA(0, 0, At, B0); PG8_BAR; PG8_SCHED;
            PG8_LDB(B1, 1, 1); PG8_STAGE(PG8_SB(1, 0), b3, voffB);
            PG8_BAR; PG8_WAIT_L(0); PG8_MMA(0, 1, At, B1); PG8_BAR;
            PG8_LDA(At, 1, 1); PG8_STAGE(PG8_SA(1, 0), a3, voffA);
            PG8_BAR; PG8_WAIT_L(0); PG8_MMA(1, 0, At, B0); PG8_BAR; PG8_SCHED;
            PG8_STAGE(PG8_SB(1, 1), b3 + hstep, voffB);
            PG8_WAIT_V(6); PG8_BAR; PG8_MMA(1, 1, At, B1); PG8_BAR;
            }
        }
        if constexpr (ALIGN_EPI) { if (wr == 0) PG8_BAR; }
        if constexpr (!Epi::AFTER_DRAIN) { E(acc, cur, wr, wc, fr, fq); S.done(cur); }
        if (!has_next) break;
#pragma unroll
        for (int a = 0; a < 2; ++a)
#pragma unroll
            for (int b = 0; b < 2; ++b)
#pragma unroll
                for (int m = 0; m < 4; ++m)
#pragma unroll
                    for (int n = 0; n < 2; ++n) acc[a][b][m][n] = (f32x4){0.f, 0.f, 0.f, 0.f};
        cur = nxt; cA = nA; cB = nB; ++ui;
        if constexpr (ALIGN_EPI) { if (wr == 1) PG8_BAR; }
    }
    PG8_WAIT_V(0);
    if constexpr (!ALIGN_EPI) { if (wr == 0) PG8_BAR; }
    PG8_BAR;
    if constexpr (Epi::AFTER_DRAIN) { E.fused(acc, cur, wr, wc, fr, fq, lds, wid, lane); S.done(cur); }
#undef PG8_SA
#undef PG8_SB
#undef PG8_STAGE
#undef PG8_LDA
#undef PG8_LDB
#undef PG8_MMA
#undef PG8_WAIT_V
#undef PG8_WAIT_L
#undef PG8_BAR
#undef PG8_SCHED
}
}

#ifndef NSA_ZERO
#define NSA_ZERO 0
#endif

#define LAS __attribute__((address_space(3)))
typedef unsigned short bf16_t;
typedef short bf16x8 __attribute__((ext_vector_type(8)));
typedef short bf16x4 __attribute__((ext_vector_type(4)));
typedef float f32x4 __attribute__((ext_vector_type(4)));
typedef unsigned u32x4 __attribute__((ext_vector_type(4)));
typedef unsigned u32x2 __attribute__((ext_vector_type(2)));

constexpr int BATCH = 32, T = 2048, M = BATCH * T, DM = 1024, DEPTH = 2;
constexpr int NPROJ = 3584, INW = 3352, DFF = 2816;
constexpr int C_HQ = 0, C_HF = 512, C_HI = 1024, C_HG = 1536, C_NQ = 2048, C_KC = 2560, C_VC = 2688, C_KS = 2816, C_VS = 2944, C_KW = 3072, C_VW = 3200, C_GT = 3328;
constexpr float RMS_EPS = 1e-6f;
constexpr size_t MiB = 1u << 20;
constexpr size_t WS_CTL = 0, WS_WIN = 1 * MiB, WS_WOUT = 15 * MiB, WS_WFFI = 19 * MiB, WS_WFFO = 41 * MiB, WS_W1T = 52 * MiB, WS_W2T = 56 * MiB;
constexpr size_t WS_XN = 64 * MiB, WS_MIX = 192 * MiB, WS_LOGF = 320 * MiB, WS_PROJ = 448 * MiB, WS_QN = 896 * MiB;
constexpr size_t AX_KS = 0, AX_KW = 16 * MiB, AX_VST = 32 * MiB, AX_VWT = 48 * MiB, AX_KC = 64 * MiB, AX_VCT = 65 * MiB;
constexpr size_t WS_RS = 960 * MiB, WS_END = 961 * MiB;
constexpr size_t WS_XBAR = WS_CTL + 655360;
constexpr size_t WS_QCTR = WS_CTL + 720896;
constexpr int LDS_BYTES = 143360;
constexpr int NTHREADS = 512;

struct Params { const float* in[17]; float* out; unsigned char* ws; int ph_lo, ph_hi; unsigned char prog[48]; };

__device__ __forceinline__ float bf2f(bf16_t v) { return __uint_as_float(((unsigned)v) << 16); }
__device__ __forceinline__ unsigned pk2(float lo, float hi) { unsigned r; asm("v_cvt_pk_bf16_f32 %0, %1, %2" : "=v"(r) : "v"(lo), "v"(hi)); return r; }
__device__ __forceinline__ bf16_t f2bf(float f) { return (bf16_t)(pk2(f, 0.f) & 0xffffu); }
__device__ __forceinline__ float wave_sum(float v) {
#pragma unroll
    for (int o = 1; o < 64; o <<= 1) v += __shfl_xor(v, o);
    return v;
}
__device__ __forceinline__ float fast_sigmoid(float x) { return __builtin_amdgcn_rcpf(1.f + __expf(-x)); }
__device__ __forceinline__ float fast_silu(float x) { return x * fast_sigmoid(x); }
#define LDS_WAIT() asm volatile("s_waitcnt lgkmcnt(0)" ::: "memory")
#define LDS_BARRIER() do { asm volatile("s_waitcnt lgkmcnt(0)" ::: "memory"); __builtin_amdgcn_s_barrier(); asm volatile("" ::: "memory"); } while (0)
#define MFMA16(a, b, c) __builtin_amdgcn_mfma_f32_16x16x32_bf16((a), (b), (c), 0, 0, 0)

struct EpiProj {
    static constexpr bool PERM = true, AFTER_DRAIN = false;
    bf16_t* P; float* LOGF; const float* lb; const float* rss;
    __device__ __forceinline__ void operator()(const f32x4 (&acc)[2][2][4][2], const pg8::Unit& u, int wr, int wc, int fr, int fq) const {
        const int row0 = u.pm * 256 + wr * 64 + fr;
        const int col0 = u.pn * 256 + wc * 32 + 8 * fq;
        float rstdv[2][4];
#pragma unroll
        for (int ai = 0; ai < 2; ++ai)
#pragma unroll
            for (int m = 0; m < 4; ++m) rstdv[ai][m] = rss[row0 + ai * 128 + m * 16];
#pragma unroll
        for (int ai = 0; ai < 2; ++ai)
#pragma unroll
            for (int m = 0; m < 4; ++m) rstdv[ai][m] = __builtin_amdgcn_rsqf(rstdv[ai][m] * (1.f / DM) + RMS_EPS);
        __builtin_amdgcn_sched_barrier(0);
        if (u.pn == 2 || u.pn == 3) {
#pragma unroll
            for (int bj = 0; bj < 2; ++bj) {
                const int cc = col0 + bj * 128 - C_HF;
                const f32x4 l0 = *(const f32x4*)(lb + cc), l1 = *(const f32x4*)(lb + cc + 4);
#pragma unroll
                for (int ai = 0; ai < 2; ++ai)
#pragma unroll
                    for (int m = 0; m < 4; ++m) {
                        const float rstd = rstdv[ai][m];
                        const f32x4 z0 = acc[ai][bj][m][0] * rstd, z1 = acc[ai][bj][m][1] * rstd;
                        f32x4 o0, o1;
#pragma unroll
                        for (int e = 0; e < 4; ++e) {
                            const float s0 = __builtin_amdgcn_rcpf(1.f + __expf(-z0[e])), s1 = __builtin_amdgcn_rcpf(1.f + __expf(-z1[e]));
                            o0[e] = __logf(l0[e] + (1.f - l0[e]) * s0); o1[e] = __logf(l1[e] + (1.f - l1[e]) * s1);
                        }
                        float* dst = LOGF + (size_t)(row0 + ai * 128 + m * 16) * 512 + cc;
                        *(f32x4*)dst = o0; *(f32x4*)(dst + 4) = o1;
                    }
            }
        } else {
#pragma unroll
            for (int ai = 0; ai < 2; ++ai)
#pragma unroll
                for (int m = 0; m < 4; ++m) {
                    bf16_t* rowp = P + (size_t)(row0 + ai * 128 + m * 16) * NPROJ + col0;
                    const float rstd = rstdv[ai][m];
#pragma unroll
                    for (int bj = 0; bj < 2; ++bj) {
                        const f32x4 v0 = acc[ai][bj][m][0] * rstd, v1 = acc[ai][bj][m][1] * rstd;
                        u32x4 w; w.x = pk2(v0[0], v0[1]); w.y = pk2(v0[2], v0[3]); w.z = pk2(v1[0], v1[1]); w.w = pk2(v1[2], v1[3]);
                        *(u32x4*)(rowp + bj * 128) = w;
                    }
                }
        }
    }
};
struct EpiRes {
    static constexpr bool PERM = true, AFTER_DRAIN = false;
    bf16_t* HB; float* outf; float* rss;
    __device__ __forceinline__ void operator()(const f32x4 (&acc)[2][2][4][2], const pg8::Unit& u, int wr, int wc, int fr, int fq) const {
        const int row0 = u.pm * 256 + wr * 64 + fr;
        const int col0 = u.pn * 256 + wc * 32 + 8 * fq;
        u32x4 buf[2][2][2];
#define ERES_LOAD(slot, q) do { _Pragma("unroll") for (int mm = 0; mm < 2; ++mm) _Pragma("unroll") for (int bj = 0; bj < 2; ++bj) \
            buf[slot][mm][bj] = *(const u32x4*)(HB + (size_t)(row0 + ((q) >> 1) * 128 + (2 * ((q) & 1) + mm) * 16) * DM + col0 + bj * 128); } while (0)
        ERES_LOAD(0, 0); ERES_LOAD(1, 1);
#pragma unroll
        for (int q = 0; q < 4; ++q) {
            const int ai = q >> 1, slot = q & 1;
#pragma unroll
            for (int mm = 0; mm < 2; ++mm) {
                const int m = 2 * (q & 1) + mm;
                const int row = row0 + ai * 128 + m * 16;
                const size_t off = (size_t)row * DM + col0;
                float ssq = 0.f;
#pragma unroll
                for (int bj = 0; bj < 2; ++bj) {
                    const u32x4 hb = buf[slot][mm][bj];
                    f32x4 o0, o1;
                    o0[0] = __uint_as_float(hb.x << 16) + acc[ai][bj][m][0][0]; o0[1] = __uint_as_float(hb.x & 0xffff0000u) + acc[ai][bj][m][0][1];
                    o0[2] = __uint_as_float(hb.y << 16) + acc[ai][bj][m][0][2]; o0[3] = __uint_as_float(hb.y & 0xffff0000u) + acc[ai][bj][m][0][3];
                    o1[0] = __uint_as_float(hb.z << 16) + acc[ai][bj][m][1][0]; o1[1] = __uint_as_float(hb.z & 0xffff0000u) + acc[ai][bj][m][1][1];
                    o1[2] = __uint_as_float(hb.w << 16) + acc[ai][bj][m][1][2]; o1[3] = __uint_as_float(hb.w & 0xffff0000u) + acc[ai][bj][m][1][3];
                    if (outf) { *(f32x4*)(outf + off + bj * 128) = o0; *(f32x4*)(outf + off + bj * 128 + 4) = o1; }
                    else {
                        ssq += (o0[0] * o0[0] + o0[1] * o0[1]) + (o0[2] * o0[2] + o0[3] * o0[3]) + (o1[0] * o1[0] + o1[1] * o1[1]) + (o1[2] * o1[2] + o1[3] * o1[3]);
                        u32x4 w; w.x = pk2(o0[0], o0[1]); w.y = pk2(o0[2], o0[3]); w.z = pk2(o1[0], o1[1]); w.w = pk2(o1[2], o1[3]);
                        *(u32x4*)(HB + off + bj * 128) = w;
                    }
                }
                if (!outf) {
                    ssq += __shfl_xor(ssq, 16); ssq += __shfl_xor(ssq, 32);
                    if (fq == 0) (void)__hip_atomic_fetch_add(rss + row, ssq, __ATOMIC_RELAXED, __HIP_MEMORY_SCOPE_AGENT);
                }
            }
            if (q + 2 < 4) { if (slot == 0) ERES_LOAD(0, q + 2); else ERES_LOAD(1, q + 2); }
            __builtin_amdgcn_sched_barrier(0);
        }
#undef ERES_LOAD
    }
};
struct EpiSwiGLU {
    static constexpr bool PERM = true, AFTER_DRAIN = false;
    bf16_t* A; const float* rss;
    __device__ __forceinline__ void operator()(const f32x4 (&acc)[2][2][4][2], const pg8::Unit& u, int wr, int wc, int fr, int fq) const {
        const int row0 = u.pm * 256 + wr * 64 + fr;
        const int col0 = u.pn * 128 + wc * 32 + 8 * fq;
        float rstdv[2][4];
#pragma unroll
        for (int ai = 0; ai < 2; ++ai)
#pragma unroll
            for (int m = 0; m < 4; ++m) rstdv[ai][m] = rss[row0 + ai * 128 + m * 16];
#pragma unroll
        for (int ai = 0; ai < 2; ++ai)
#pragma unroll
            for (int m = 0; m < 4; ++m) rstdv[ai][m] = __builtin_amdgcn_rsqf(rstdv[ai][m] * (1.f / DM) + RMS_EPS);
        __builtin_amdgcn_sched_barrier(0);
#pragma unroll
        for (int ai = 0; ai < 2; ++ai)
#pragma unroll
            for (int m = 0; m < 4; ++m) {
                const float rstd = rstdv[ai][m];
                const f32x4 g0 = acc[ai][0][m][0] * rstd, g1 = acc[ai][0][m][1] * rstd, u0 = acc[ai][1][m][0] * rstd, u1 = acc[ai][1][m][1] * rstd;
                float r[8];
#pragma unroll
                for (int e = 0; e < 4; ++e) { r[e] = fast_silu(g0[e]) * u0[e]; r[4 + e] = fast_silu(g1[e]) * u1[e]; }
                u32x4 w; w.x = pk2(r[0], r[1]); w.y = pk2(r[2], r[3]); w.z = pk2(r[4], r[5]); w.w = pk2(r[6], r[7]);
                *(u32x4*)(A + (size_t)(row0 + ai * 128 + m * 16) * DFF + col0) = w;
            }
    }
};

__device__ __forceinline__ void transpose_item(const float* __restrict__ W, int K, int N, int nblk, bf16_t* WT, int mode, const float* gk, LAS float* scr, int item, int lane) {
    const int kb = item / nblk, nb = item % nblk, k0 = 64 * kb, n0 = 32 * nb;
    const int n = n0 + (lane & 31);
#pragma unroll 8
    for (int i = 0; i < 32; ++i) { const int kk = 2 * i + (lane >> 5); scr[kk * 33 + (lane & 31)] = (n < N) ? W[(size_t)(k0 + kk) * N + n] * (gk ? gk[k0 + kk] : 1.f) : 0.f; }
    LDS_WAIT();
    const int c = lane & 7;
#pragma unroll
    for (int j = 0; j < 4; ++j) {
        const int nl = (lane >> 3) + 8 * j, nn = n0 + nl;
        int row = nn;
        if (mode == 1) row = (nn < DFF) ? ((nn >> 7) * 256 + (nn & 127)) : ((((nn - DFF) >> 7) * 256) + 128 + ((nn - DFF) & 127));
        const LAS float* s = scr + (8 * c) * 33 + nl;
        u32x4 o; o.x = pk2(s[0 * 33], s[1 * 33]); o.y = pk2(s[2 * 33], s[3 * 33]); o.z = pk2(s[4 * 33], s[5 * 33]); o.w = pk2(s[6 * 33], s[7 * 33]);
        *(u32x4*)(WT + (size_t)row * K + k0 + 8 * c) = o;
    }
    LDS_WAIT();
}
__device__ __forceinline__ void gain_row_to_bf16(const float* xrow, bf16_t* orow, float* rs, int lane) {
    const f32x4* xr = (const f32x4*)xrow + lane;
    f32x4 v[4]; float s = 0.f;
#pragma unroll
    for (int j = 0; j < 4; ++j) { v[j] = xr[64 * j]; s += (v[j].x * v[j].x + v[j].y * v[j].y) + (v[j].z * v[j].z + v[j].w * v[j].w); }
    s = wave_sum(s);
    if (lane == 0) *rs = s;
    unsigned long long* o8 = (unsigned long long*)orow + lane;
#pragma unroll
    for (int j = 0; j < 4; ++j) o8[64 * j] = (unsigned long long)pk2(v[j].x, v[j].y) | ((unsigned long long)pk2(v[j].z, v[j].w) << 32);
}
__device__ __forceinline__ void weights_phase(const Params& p, LAS unsigned char* lds, int gw, int NGW, int wave, int lane, int l) {
    LAS float* scr = (LAS float*)(lds + wave * 16384);
    unsigned char* ws = p.ws;
    constexpr int I_IN = 16 * 112, I_OUT = 16 * 32, I_FFI = 16 * 176, I_FFO = 44 * 32, I_W1 = 32 * 8, I_W2 = 4 * 2;
    constexpr int PER_LAYER = I_IN + I_OUT + I_FFI + I_FFO + 2 * I_W1 + 2 * I_W2;
    for (int it = gw; it < PER_LAYER; it += NGW) {
        int r = it;
        if (r < I_IN) { transpose_item(p.in[1] + (size_t)l * DM * INW, DM, INW, 112, (bf16_t*)(ws + WS_WIN) + (size_t)l * NPROJ * DM, 0, p.in[15] + l * DM, scr, r, lane); continue; } r -= I_IN;
        if (r < I_OUT) { transpose_item(p.in[2] + (size_t)l * DM * DM, DM, DM, 32, (bf16_t*)(ws + WS_WOUT) + (size_t)l * DM * DM, 0, nullptr, scr, r, lane); continue; } r -= I_OUT;
        if (r < I_FFI) { transpose_item(p.in[13] + (size_t)l * DM * 2 * DFF, DM, 2 * DFF, 176, (bf16_t*)(ws + WS_WFFI) + (size_t)l * 2 * DFF * DM, 1, p.in[16] + l * DM, scr, r, lane); continue; } r -= I_FFI;
        if (r < I_FFO) { transpose_item(p.in[14] + (size_t)l * DFF * DM, DFF, DM, 32, (bf16_t*)(ws + WS_WFFO) + (size_t)l * DM * DFF, 0, nullptr, scr, r, lane); continue; } r -= I_FFO;
        if (r < I_W1) { transpose_item(p.in[8] + (size_t)l * 2048 * 256, 2048, 256, 8, (bf16_t*)(ws + WS_W1T) + (size_t)(l * 2 + 0) * 256 * 2048, 0, nullptr, scr, r, lane); continue; } r -= I_W1;
        if (r < I_W1) { transpose_item(p.in[11] + (size_t)l * 2048 * 256, 2048, 256, 8, (bf16_t*)(ws + WS_W1T) + (size_t)(l * 2 + 1) * 256 * 2048, 0, nullptr, scr, r, lane); continue; } r -= I_W1;
        if (r < I_W2) { transpose_item(p.in[9] + (size_t)l * 256 * 64, 256, 64, 2, (bf16_t*)(ws + WS_W2T) + (size_t)(l * 2 + 0) * 64 * 256, 0, nullptr, scr, r, lane); continue; } r -= I_W2;
        transpose_item(p.in[12] + (size_t)l * 256 * 64, 256, 64, 2, (bf16_t*)(ws + WS_W2T) + (size_t)(l * 2 + 1) * 64 * 256, 0, nullptr, scr, r, lane);
    }
}
__device__ __forceinline__ void prologue_phase(const Params& p, LAS unsigned char* lds, int gw, int NGW, int wave, int lane) {
    unsigned char* ws = p.ws;
    for (int l = 0; l < DEPTH; ++l) weights_phase(p, lds, gw, NGW, wave, lane, l);
    if (gw == 0) {
        unsigned* ctl = (unsigned*)(ws + WS_CTL);
        if (lane < 48) ctl[64 * lane] = 0u;
        for (int i = lane; i < 48 * 8; i += 64) ((unsigned*)(ws + WS_QCTR))[64 * i] = 0u;
        {
            float* M0T = (float*)(ws + WS_CTL + 24576);
            for (int l = 0; l < DEPTH; ++l) {
                float gq = fabsf(p.in[5][l * 64 + lane]), g0 = fabsf(p.in[6][l * 192 + lane]), g1 = fabsf(p.in[6][l * 192 + 64 + lane]), g2 = fabsf(p.in[6][l * 192 + 128 + lane]);
#pragma unroll
                for (int ofs = 1; ofs < 64; ofs <<= 1) { gq = fmaxf(gq, __shfl_xor(gq, ofs)); g0 = fmaxf(g0, __shfl_xor(g0, ofs)); g1 = fmaxf(g1, __shfl_xor(g1, ofs)); g2 = fmaxf(g2, __shfl_xor(g2, ofs)); }
                const float c = 64.f * 0.125f * 1.4426950408889634f * 1.001f;
                if (lane == 0) { M0T[4 * l + 0] = c * gq * g0; M0T[4 * l + 1] = c * gq * g1; M0T[4 * l + 2] = c * gq * g2; }
            }
        }
        float* LB = (float*)(ws + WS_CTL + 16384);
        for (int c = lane; c < 512; c += 64) { const float l0 = p.in[3][c], l1 = p.in[3][512 + c]; LB[c] = 0.f; LB[512 + c] = 1.f / (1.f + expf(l0 - l1)); }
    }
    {
        float* CS = (float*)(ws + WS_CTL + 65536);
        for (int idx = gw * 64 + lane; idx < T * 32; idx += NGW * 64) { float sn, cs; sincosf((float)(idx >> 5) * exp2f(-(float)(idx & 31) * 0.41524101186092034f), &sn, &cs); CS[2 * idx] = cs; CS[2 * idx + 1] = sn; }
    }
    float* RS = (float*)(ws + WS_RS);
    for (int m = gw; m < M; m += 4 * NGW) {
        f32x4 v[4][4]; float s[4];
#pragma unroll
        for (int r = 0; r < 4; ++r) { const f32x4* xr = (const f32x4*)(p.in[0] + (size_t)(m + r * NGW) * DM) + lane;
#pragma unroll
            for (int j = 0; j < 4; ++j) v[r][j] = xr[64 * j]; }
#pragma unroll
        for (int r = 0; r < 4; ++r) { s[r] = 0.f;
#pragma unroll
            for (int j = 0; j < 4; ++j) s[r] += (v[r][j].x * v[r][j].x + v[r][j].y * v[r][j].y) + (v[r][j].z * v[r][j].z + v[r][j].w * v[r][j].w); }
#pragma unroll
        for (int o = 1; o < 64; o <<= 1) {
#pragma unroll
            for (int r = 0; r < 4; ++r) s[r] += __shfl_xor(s[r], o); }
#pragma unroll
        for (int r = 0; r < 4; ++r) {
            if (lane == 0) RS[m + r * NGW] = s[r];
            unsigned long long* o8 = (unsigned long long*)((bf16_t*)(ws + WS_XN) + (size_t)(m + r * NGW) * DM) + lane;
#pragma unroll
            for (int j = 0; j < 4; ++j) o8[64 * j] = (unsigned long long)pk2(v[r][j].x, v[r][j].y) | ((unsigned long long)pk2(v[r][j].z, v[r][j].w) << 32);
        }
    }
    for (int i = gw * 64 + lane; i < 3 * M; i += NGW * 64) RS[M + i] = 0.f;
}

constexpr float ROPE_C = 0.41524101186092034f;
constexpr float QSCALE = 0.125f * 1.4426950408889634f;
__device__ __forceinline__ void prep_item(const Params& p, int l, int item, LAS unsigned char* lds, int tid, int wave, int lane) {
    const int b = item >> 5, tc = item & 31, m0 = b * T + tc * 64;
    unsigned char* ws = p.ws; unsigned char* aux = (unsigned char*)p.out;
    const bf16_t* PROJ = (const bf16_t*)(ws + WS_PROJ);
    LAS bf16_t* Vt = (LAS bf16_t*)lds;
#pragma unroll
    for (int k = 0; k < 4; ++k) {
        const int c = tid + 512 * k, token = c >> 5, part = c & 31;
        const int col = part < 16 ? C_VS + part * 8 : C_VW + (part - 16) * 8;
        const u32x4 v = *(const u32x4*)(PROJ + (size_t)(m0 + token) * NPROJ + col);
        *(LAS u32x4*)(Vt + token * 264 + part * 8) = v;
    }
    {
        const float* CS = (const float*)(ws + WS_CTL + 65536);
        const int hsel = lane >> 3, i0 = (lane & 7) * 4, kh = hsel & 3;
        const float* qg = p.in[5] + l * 64; const float* kgp = p.in[6] + l * 192 + (kh < 2 ? 64 : 128);
        const f32x4 gqa = *(const f32x4*)(qg + i0), gqb = *(const f32x4*)(qg + 32 + i0), gka = *(const f32x4*)(kgp + i0), gkb = *(const f32x4*)(kgp + 32 + i0);
        bf16_t* QN = (bf16_t*)(ws + WS_QN);
        bf16_t* KX = (bf16_t*)(aux + (kh < 2 ? AX_KS : AX_KW));
#define PREP_ROPE(srcp, dstp, tpos, ga, gb, sc) do { \
            const u32x2 r1 = *(const u32x2*)(srcp), r2 = *(const u32x2*)((srcp) + 32); \
            const f32x4 c01 = *(const f32x4*)(CS + (size_t)(tpos) * 64 + 2 * i0), c23 = *(const f32x4*)(CS + (size_t)(tpos) * 64 + 2 * i0 + 4); \
            f32x4 x1, x2; x1[0] = __uint_as_float(r1.x << 16); x1[1] = __uint_as_float(r1.x & 0xffff0000u); x1[2] = __uint_as_float(r1.y << 16); x1[3] = __uint_as_float(r1.y & 0xffff0000u); \
            x2[0] = __uint_as_float(r2.x << 16); x2[1] = __uint_as_float(r2.x & 0xffff0000u); x2[2] = __uint_as_float(r2.y << 16); x2[3] = __uint_as_float(r2.y & 0xffff0000u); \
            float ss = (x1[0] * x1[0] + x1[1] * x1[1]) + (x1[2] * x1[2] + x1[3] * x1[3]) + (x2[0] * x2[0] + x2[1] * x2[1]) + (x2[2] * x2[2] + x2[3] * x2[3]); \
            ss += __shfl_xor(ss, 1); ss += __shfl_xor(ss, 2); ss += __shfl_xor(ss, 4); \
            const float rs_ = (sc) / sqrtf(ss * (1.f / 64.f) + RMS_EPS); \
            const f32x4 y1 = x1 * (ga) * rs_, y2 = x2 * (gb) * rs_; \
            const f32x4 cc = (f32x4){c01[0], c01[2], c23[0], c23[2]}, sn = (f32x4){c01[1], c01[3], c23[1], c23[3]}; \
            const f32x4 o1 = y1 * cc - y2 * sn, o2 = y1 * sn + y2 * cc; \
            u32x2 w1, w2; w1.x = pk2(o1[0], o1[1]); w1.y = pk2(o1[2], o1[3]); w2.x = pk2(o2[0], o2[1]); w2.y = pk2(o2[2], o2[3]); \
            *(u32x2*)(dstp) = w1; *(u32x2*)((dstp) + 32) = w2; } while (0)
#pragma unroll 4
        for (int tl = 0; tl < 8; ++tl) {
            const int token = 8 * wave + tl, t = tc * 64 + token;
            const bf16_t* sp = PROJ + (size_t)(m0 + token) * NPROJ + C_NQ + hsel * 64 + i0;
            bf16_t* dp = QN + (((size_t)(b * 2 + (hsel >> 2)) * T + t) * 4 + (hsel & 3)) * 64 + i0;
            PREP_ROPE(sp, dp, t, gqa, gqb, QSCALE);
        }
#pragma unroll
        for (int tp = 0; tp < 4; ++tp) {
            const int token = 8 * wave + 2 * tp + (lane >> 5), t = tc * 64 + token;
            const bf16_t* sp = PROJ + (size_t)(m0 + token) * NPROJ + (kh < 2 ? C_KS + kh * 64 : C_KW + (kh - 2) * 64) + i0;
            bf16_t* dp = KX + ((size_t)(b * 2 + (kh & 1)) * T + t) * 64 + i0;
            PREP_ROPE(sp, dp, t, gka, gkb, 1.f);
        }
#undef PREP_ROPE
    }
    LDS_BARRIER();
    {
        const int r = tid >> 1, h2 = tid & 1, typ = r >> 7, g = (r >> 6) & 1, d = r & 63;
        bf16_t* dst = (bf16_t*)(aux + (typ ? AX_VWT : AX_VST)) + (((size_t)(b * 2 + g) * 32 + tc) * 64 + d) * 64 + 32 * h2;
#pragma unroll
        for (int q4 = 0; q4 < 4; ++q4) {
            unsigned w[4];
#pragma unroll
            for (int k = 0; k < 4; ++k) {
                const unsigned lo = Vt[(32 * h2 + 8 * q4 + 2 * k) * 264 + r], hi = Vt[(32 * h2 + 8 * q4 + 2 * k + 1) * 264 + r];
                w[k] = lo | (hi << 16);
            }
            *(u32x4*)(dst + 8 * q4) = (u32x4){w[0], w[1], w[2], w[3]};
        }
    }
    LDS_BARRIER();
}

__device__ __forceinline__ void compress_item(const Params& p, int l, int ci, LAS unsigned char* lds, int tid, int wave, int lane) {
    const int half = ci & 1, kv = (ci >> 1) & 1, bg = ci >> 2, b = bg >> 1, g = bg & 1;
    const int quad = lane >> 4, r16 = lane & 15;
    unsigned char* ws = p.ws; unsigned char* aux = (unsigned char*)p.out;
    const bf16_t* src = (const bf16_t*)(ws + WS_PROJ) + (size_t)b * T * NPROJ + (kv ? C_VC : C_KC) + g * 64;
    const float* pe = p.in[kv ? 10 : 7] + l * 32 * 64;
    const bf16_t* W1T = (const bf16_t*)(ws + WS_W1T) + (size_t)(l * 2 + kv) * 256 * 2048;
    const bf16_t* W2T = (const bf16_t*)(ws + WS_W2T) + (size_t)(l * 2 + kv) * 64 * 256;
    LAS bf16_t* As = (LAS bf16_t*)lds;
    LAS bf16_t* Bs = (LAS bf16_t*)(lds + 17408);
    LAS bf16_t* Hs = (LAS bf16_t*)(lds + 87040);
    LAS float* Os = (LAS float*)(lds + 120832);
    f32x4 acc[4][2];
#pragma unroll
    for (int mt = 0; mt < 4; ++mt) { acc[mt][0] = (f32x4){0.f, 0.f, 0.f, 0.f}; acc[mt][1] = (f32x4){0.f, 0.f, 0.f, 0.f}; }
    const int ar = tid >> 3, ach = tid & 7, n_a = 64 * half + ar;
    u32x4 raw[2], wv[2][4]; f32x4 pe0[2], pe1[2];
#define CMP_LOAD(st_) do { _Pragma("unroll") for (int h_ = 0; h_ < 2; ++h_) { const int ls_ = 2 * (st_) + h_; int tok = 16 * n_a + ls_; tok = tok > T - 1 ? T - 1 : tok; \
        raw[h_] = *(const u32x4*)(src + (size_t)tok * NPROJ + ach * 8); pe0[h_] = *(const f32x4*)(pe + ls_ * 64 + ach * 8); pe1[h_] = *(const f32x4*)(pe + ls_ * 64 + ach * 8 + 4); \
        _Pragma("unroll") for (int k = 0; k < 4; ++k) wv[h_][k] = *(const u32x4*)(W1T + (size_t)(ar + 64 * k) * 2048 + ls_ * 64 + ach * 8); } } while (0)
    CMP_LOAD(0);
    for (int st = 0; st < 16; ++st) {
        LDS_BARRIER();
#pragma unroll
        for (int h_ = 0; h_ < 2; ++h_) {
            u32x4 o;
            o.x = pk2(__uint_as_float(raw[h_].x << 16) + pe0[h_][0], __uint_as_float(raw[h_].x & 0xffff0000u) + pe0[h_][1]);
            o.y = pk2(__uint_as_float(raw[h_].y << 16) + pe0[h_][2], __uint_as_float(raw[h_].y & 0xffff0000u) + pe0[h_][3]);
            o.z = pk2(__uint_as_float(raw[h_].z << 16) + pe1[h_][0], __uint_as_float(raw[h_].z & 0xffff0000u) + pe1[h_][1]);
            o.w = pk2(__uint_as_float(raw[h_].w << 16) + pe1[h_][2], __uint_as_float(raw[h_].w & 0xffff0000u) + pe1[h_][3]);
            *(LAS u32x4*)(As + ar * 136 + 64 * h_ + ach * 8) = o;
#pragma unroll
            for (int k = 0; k < 4; ++k) *(LAS u32x4*)(Bs + (ar + 64 * k) * 136 + 64 * h_ + ach * 8) = wv[h_][k];
        }
        if (st + 1 < 16) CMP_LOAD(st + 1);
        LDS_BARRIER();
#pragma unroll
        for (int kb = 0; kb < 4; ++kb) {
            bf16x8 bfr[2];
#pragma unroll
            for (int nt = 0; nt < 2; ++nt) bfr[nt] = *(const LAS bf16x8*)(Bs + (32 * wave + 16 * nt + r16) * 136 + 32 * kb + 8 * quad);
#pragma unroll
            for (int mt = 0; mt < 4; ++mt) {
                const bf16x8 a = *(const LAS bf16x8*)(As + (16 * mt + r16) * 136 + 32 * kb + 8 * quad);
#pragma unroll
                for (int nt = 0; nt < 2; ++nt) acc[mt][nt] = MFMA16(a, bfr[nt], acc[mt][nt]);
            }
        }
    }
#undef CMP_LOAD
    LDS_BARRIER();
#pragma unroll
    for (int mt = 0; mt < 4; ++mt)
#pragma unroll
        for (int nt = 0; nt < 2; ++nt)
#pragma unroll
            for (int e = 0; e < 4; ++e) { const float x = acc[mt][nt][e]; Hs[(16 * mt + 4 * quad + e) * 264 + 32 * wave + 16 * nt + r16] = f2bf(x / (1.f + expf(-x))); }
    LDS_BARRIER();
    {
        const int mt = wave >> 1;
        f32x4 o2[2]; o2[0] = (f32x4){0.f, 0.f, 0.f, 0.f}; o2[1] = (f32x4){0.f, 0.f, 0.f, 0.f};
#pragma unroll
        for (int kb = 0; kb < 8; ++kb) {
            const bf16x8 a = *(const LAS bf16x8*)(Hs + (16 * mt + r16) * 264 + 32 * kb + 8 * quad);
#pragma unroll
            for (int dd = 0; dd < 2; ++dd) {
                const int dt = 2 * (wave & 1) + dd;
                const bf16x8 bw = *(const bf16x8*)(W2T + (size_t)(16 * dt + r16) * 256 + 32 * kb + 8 * quad);
                o2[dd] = MFMA16(a, bw, o2[dd]);
            }
        }
#pragma unroll
        for (int dd = 0; dd < 2; ++dd)
#pragma unroll
            for (int e = 0; e < 4; ++e) Os[(16 * mt + 4 * quad + e) * 65 + 16 * (2 * (wave & 1) + dd) + r16] = o2[dd][e];
    }
    LDS_BARRIER();
    if (kv == 0) {
        const int row = tid >> 3, sub = tid & 7, n = 64 * half + row;
        float x1[4], x2[4], ss = 0.f;
#pragma unroll
        for (int k = 0; k < 4; ++k) { x1[k] = Os[row * 65 + 4 * sub + k]; x2[k] = Os[row * 65 + 32 + 4 * sub + k]; ss += x1[k] * x1[k] + x2[k] * x2[k]; }
        ss += __shfl_xor(ss, 1); ss += __shfl_xor(ss, 2); ss += __shfl_xor(ss, 4);
        const float rstd = 1.f / sqrtf(ss * (1.f / 64.f) + RMS_EPS);
        const float* kg = p.in[6] + l * 192;
        const float* CSt = (const float*)(ws + WS_CTL + 65536);
        bf16_t* dst = (bf16_t*)(aux + AX_KC) + ((size_t)bg * 128 + n) * 64;
#pragma unroll
        for (int k = 0; k < 4; ++k) {
            const int i = 4 * sub + k;
            const float cs = CSt[(16 * (n > 126 ? 126 : n) + 31) * 64 + 2 * i], sn = CSt[(16 * (n > 126 ? 126 : n) + 31) * 64 + 2 * i + 1];
            const float y1 = x1[k] * rstd * kg[i], y2 = x2[k] * rstd * kg[i + 32];
            float o1 = y1 * cs - y2 * sn, o2v = y1 * sn + y2 * cs;
            if (n >= 127) { o1 = 0.f; o2v = 0.f; }
            dst[i] = f2bf(o1); dst[i + 32] = f2bf(o2v);
        }
    } else {
        const int d = tid >> 3, sub = tid & 7;
        float v[8];
#pragma unroll
        for (int k = 0; k < 8; ++k) { const int r = 8 * sub + k, n = 64 * half + r; v[k] = (n >= 127) ? 0.f : Os[r * 65 + d]; }
        u32x4 o; o.x = pk2(v[0], v[1]); o.y = pk2(v[2], v[3]); o.z = pk2(v[4], v[5]); o.w = pk2(v[6], v[7]);
        *(u32x4*)((bf16_t*)(aux + AX_VCT) + ((size_t)bg * 64 + d) * 128 + 64 * half + 8 * sub) = o;
    }
    LDS_BARRIER();
}

__device__ __forceinline__ void hgrn_item(const Params& p, int l, int item, LAS unsigned char* lds, int tid, int wave, int lane) {
    const int b = item >> 2, h = item & 3;
    const int quad = lane >> 4, r16 = lane & 15;
    unsigned char* ws = p.ws; unsigned char* aux = (unsigned char*)p.out;
    const bf16_t* PROJ = (const bf16_t*)(ws + WS_PROJ);
    const float* LOGF = (const float*)(ws + WS_LOGF);
    bf16_t* MIX = (bf16_t*)(ws + WS_MIX);
    const float* gnorm = p.in[4] + l * 128;
    LAS bf16_t* Qt = (LAS bf16_t*)lds;
    LAS bf16_t* Kt = (LAS bf16_t*)(lds + 17408);
    LAS float* Ob = (LAS float*)lds;
    LAS bf16_t* Qh = (LAS bf16_t*)(lds + 34816);
    LAS bf16_t* KhT = (LAS bf16_t*)(lds + 52224);
    LAS bf16_t* VT = (LAS bf16_t*)(lds + 70656);
    LAS bf16_t* As = (LAS bf16_t*)(lds + 89088);
    LAS bf16_t* ST = (LAS bf16_t*)(lds + 98304);
    LAS float* TOT = (LAS float*)(lds + 133120);
    LAS float* DEC = (LAS float*)(lds + 135168);
    const int d = tid & 127, seg = tid >> 7;
    for (int i = tid; i < 34816 / 16; i += NTHREADS) ((LAS u32x4*)ST)[i] = (u32x4){0u, 0u, 0u, 0u};
    f32x4 S[8];
#pragma unroll
    for (int vt = 0; vt < 8; ++vt) S[vt] = (f32x4){0.f, 0.f, 0.f, 0.f};
    __syncthreads();
    for (int c = 0; c < 32; ++c) {
        const int m0 = b * T + c * 64;
        float bl[16], qs[16], lf[16];
        {
            float cum = 0.f;
#pragma unroll
            for (int r = 0; r < 16; ++r) {
                const int row = seg * 16 + r;
                const bf16_t* pr = PROJ + (size_t)(m0 + row) * NPROJ + h * 128 + d;
                lf[r] = LOGF[(size_t)(m0 + row) * 512 + h * 128 + d];
                const float q = bf2f(pr[C_HQ]);
                qs[r] = q * __builtin_amdgcn_rcpf(1.f + __expf(-q));
                VT[d * 72 + row] = pr[C_HI];
                cum += lf[r]; bl[r] = cum;
            }
            TOT[seg * 128 + d] = cum;
        }
        LDS_BARRIER();
        {
            const float t0 = TOT[d], t1 = TOT[128 + d], t2 = TOT[256 + d], t3 = TOT[384 + d];
            const float off = seg == 0 ? 0.f : (seg == 1 ? t0 : (seg == 2 ? t0 + t1 : t0 + t1 + t2));
            const float bmid = t0 + t1, blast = (t0 + t1) + (t2 + t3);
            if (seg == 0) DEC[d] = __expf(blast);
#pragma unroll
            for (int r = 0; r < 16; ++r) {
                const int row = seg * 16 + r;
                const float bb = off + bl[r];
                const float k = 1.f - __expf(lf[r]);
                Qt[row * 136 + d] = f2bf(qs[r] * __expf(bb - bmid));
                Kt[row * 136 + d] = f2bf(k * __expf(bmid - bb));
                Qh[row * 136 + d] = f2bf(qs[r] * __expf(bb));
                KhT[d * 72 + row] = f2bf(k * __expf(blast - bb));
            }
        }
        LDS_BARRIER();
        {
            const int tt = wave >> 1, st0 = 2 * (wave & 1);
            f32x4 a2[2]; a2[0] = (f32x4){0.f, 0.f, 0.f, 0.f}; a2[1] = (f32x4){0.f, 0.f, 0.f, 0.f};
#pragma unroll
            for (int kb = 0; kb < 4; ++kb) {
                const bf16x8 a = *(const LAS bf16x8*)(Qt + (16 * tt + r16) * 136 + 32 * kb + 8 * quad);
#pragma unroll
                for (int j = 0; j < 2; ++j) { const bf16x8 bq = *(const LAS bf16x8*)(Kt + (16 * (st0 + j) + r16) * 136 + 32 * kb + 8 * quad); a2[j] = MFMA16(a, bq, a2[j]); }
            }
#pragma unroll
            for (int j = 0; j < 2; ++j)
#pragma unroll
                for (int e = 0; e < 4; ++e) { const int t = 16 * tt + 4 * quad + e, s = 16 * (st0 + j) + r16; As[t * 72 + s] = f2bf(s <= t ? a2[j][e] : 0.f); }
        }
        LDS_BARRIER();
        {
            const int tt = wave & 3, vt0 = 4 * (wave >> 2);
            f32x4 o4[4];
#pragma unroll
            for (int j = 0; j < 4; ++j) o4[j] = (f32x4){0.f, 0.f, 0.f, 0.f};
#pragma unroll
            for (int kb = 0; kb < 2; ++kb) {
                const bf16x8 a = *(const LAS bf16x8*)(As + (16 * tt + r16) * 72 + 32 * kb + 8 * quad);
#pragma unroll
                for (int j = 0; j < 4; ++j) { const bf16x8 bv = *(const LAS bf16x8*)(VT + (16 * (vt0 + j) + r16) * 72 + 32 * kb + 8 * quad); o4[j] = MFMA16(a, bv, o4[j]); }
            }
#pragma unroll
            for (int kb = 0; kb < 4; ++kb) {
                const bf16x8 a = *(const LAS bf16x8*)(Qh + (16 * tt + r16) * 136 + 32 * kb + 8 * quad);
#pragma unroll
                for (int j = 0; j < 4; ++j) { const bf16x8 bs = *(const LAS bf16x8*)(ST + (16 * (vt0 + j) + r16) * 136 + 32 * kb + 8 * quad); o4[j] = MFMA16(a, bs, o4[j]); }
            }
#pragma unroll
            for (int j = 0; j < 4; ++j)
#pragma unroll
                for (int e = 0; e < 4; ++e) Ob[(16 * tt + 4 * quad + e) * 132 + 16 * (vt0 + j) + r16] = o4[j][e];
        }
        {
            const f32x4 dec = *(const LAS f32x4*)(DEC + 16 * wave + 4 * quad);
#pragma unroll
            for (int vt = 0; vt < 8; ++vt) S[vt] = S[vt] * dec;
#pragma unroll
            for (int kb = 0; kb < 2; ++kb) {
                const bf16x8 a = *(const LAS bf16x8*)(KhT + (16 * wave + r16) * 72 + 32 * kb + 8 * quad);
#pragma unroll
                for (int vt = 0; vt < 8; ++vt) { const bf16x8 bv = *(const LAS bf16x8*)(VT + (16 * vt + r16) * 72 + 32 * kb + 8 * quad); S[vt] = MFMA16(a, bv, S[vt]); }
            }
        }
        LDS_BARRIER();
#pragma unroll
        for (int vt = 0; vt < 8; ++vt) { u32x2 w; w.x = pk2(S[vt][0], S[vt][1]); w.y = pk2(S[vt][2], S[vt][3]); *(LAS u32x2*)(ST + (16 * vt + r16) * 136 + 16 * wave + 4 * quad) = w; }
        {
            const int row = tid >> 3, sub = tid & 7;
            float ov[16], ss = 0.f;
#pragma unroll
            for (int k = 0; k < 16; ++k) { ov[k] = Ob[row * 132 + 16 * sub + k]; ss += ov[k] * ov[k]; }
            ss += __shfl_xor(ss, 1); ss += __shfl_xor(ss, 2); ss += __shfl_xor(ss, 4);
            const float rstd = __builtin_amdgcn_rsqf(ss * (1.f / 128.f) + RMS_EPS);
            const bf16_t* gp = PROJ + (size_t)(m0 + row) * NPROJ + C_HG + h * 128 + 16 * sub;
            const u32x4 g0 = *(const u32x4*)gp, g1 = *(const u32x4*)(gp + 8);
            const unsigned gw[8] = {g0.x, g0.y, g0.z, g0.w, g1.x, g1.y, g1.z, g1.w};
            unsigned w[8];
#pragma unroll
            for (int k = 0; k < 8; ++k) {
                const float ga = __uint_as_float(gw[k] << 16), gb = __uint_as_float(gw[k] & 0xffff0000u);
                const float ra = ov[2 * k] * rstd * gnorm[16 * sub + 2 * k] * (ga * __builtin_amdgcn_rcpf(1.f + __expf(-ga)));
                const float rb = ov[2 * k + 1] * rstd * gnorm[16 * sub + 2 * k + 1] * (gb * __builtin_amdgcn_rcpf(1.f + __expf(-gb)));
                w[k] = pk2(ra, rb);
            }
            bf16_t* dst = MIX + (size_t)(m0 + row) * DM + h * 128 + 16 * sub;
            *(u32x4*)dst = (u32x4){w[0], w[1], w[2], w[3]}; *(u32x4*)(dst + 8) = (u32x4){w[4], w[5], w[6], w[7]};
        }
        LDS_BARRIER();
    }
}

__device__ __forceinline__ void hgrn_item_naive(const Params& p, int l, int item, LAS unsigned char* lds, int tid, int wave, int lane) {
    const int b = item >> 2, h = item & 3;
    unsigned char* ws = p.ws; unsigned char* aux = (unsigned char*)p.out;
    const bf16_t* PROJ = (const bf16_t*)(ws + WS_PROJ);
    const float* LOGF = (const float*)(ws + WS_LOGF);
    bf16_t* MIX = (bf16_t*)(ws + WS_MIX);
    const float* gnorm = p.in[4] + l * 128;
    LAS float* Ob = (LAS float*)lds;
    LAS float* Fq = (LAS float*)(lds + 33792);
    LAS float* Ff = (LAS float*)(lds + 66560);
    LAS float* Pp = (LAS float*)(lds + 99328);
    const int v = tid & 127, dg = tid >> 7;
    float S[32];
#pragma unroll
    for (int i = 0; i < 32; ++i) S[i] = 0.f;
    for (int c = 0; c < 32; ++c) {
        const int m0 = b * T + c * 64;
        float vv[16];
        {
            const int d = tid & 127, seg = tid >> 7;
#pragma unroll
            for (int r = 0; r < 16; ++r) {
                const int row = seg * 16 + r;
                const bf16_t* pr = PROJ + (size_t)(m0 + row) * NPROJ + h * 128 + d;
                const float lf = LOGF[(size_t)(m0 + row) * 512 + h * 128 + d];
                const float q = bf2f(pr[C_HQ]);
                Fq[row * 128 + d] = q / (1.f + expf(-q));
                Ff[row * 128 + d] = expf(lf);
            }
        }
        __syncthreads();
        for (int t = 0; t < 64; ++t) {
            const float vt = bf2f(PROJ[(size_t)(m0 + t) * NPROJ + C_HI + h * 128 + v]);
            float part = 0.f;
#pragma unroll
            for (int i4 = 0; i4 < 8; ++i4) {
                const f32x4 f4 = *(const LAS f32x4*)(Ff + t * 128 + dg * 32 + 4 * i4);
                const f32x4 q4 = *(const LAS f32x4*)(Fq + t * 128 + dg * 32 + 4 * i4);
#pragma unroll
                for (int e = 0; e < 4; ++e) { const int i = 4 * i4 + e; S[i] = f4[e] * S[i] + (1.f - f4[e]) * vt; part += q4[e] * S[i]; }
            }
            Pp[(t & 1) * 512 + dg * 128 + v] = part;
            __syncthreads();
            if (dg == 0) Ob[t * 132 + v] = (Pp[(t & 1) * 512 + v] + Pp[(t & 1) * 512 + 128 + v]) + (Pp[(t & 1) * 512 + 256 + v] + Pp[(t & 1) * 512 + 384 + v]);
        }
        __syncthreads();
        {
            const int row = tid >> 3, sub = tid & 7;
            float ov[16], ss = 0.f;
#pragma unroll
            for (int k = 0; k < 16; ++k) { ov[k] = Ob[row * 132 + 16 * sub + k]; ss += ov[k] * ov[k]; }
            ss += __shfl_xor(ss, 1); ss += __shfl_xor(ss, 2); ss += __shfl_xor(ss, 4);
            const float rstd = 1.f / sqrtf(ss * (1.f / 128.f) + RMS_EPS);
            const bf16_t* gp = PROJ + (size_t)(m0 + row) * NPROJ + C_HG + h * 128 + 16 * sub;
            bf16_t* dst = MIX + (size_t)(m0 + row) * DM + h * 128 + 16 * sub;
#pragma unroll
            for (int k = 0; k < 16; ++k) { const float ga = bf2f(gp[k]); dst[k] = f2bf(ov[k] * rstd * gnorm[16 * sub + k] * (ga / (1.f + expf(-ga)))); }
        }
        __syncthreads();
    }
}
#define XB_TMO      128
#define XB_XCNT(j)  (256  + 64 * (j))
#define XB_XSUB(j)  (1280 + 64 * (j))
#define XB_XGEN(j)  (2304 + 64 * (j))
#define XB_TOP      3328
#define XB_TOPGEN   3392
#define XCD_BAR_WORDS 3456
#define XB_SPIN_CAP (1u << 18)

__device__ __forceinline__ unsigned xb_ld(unsigned* p)              { return __hip_atomic_load(p, __ATOMIC_RELAXED, __HIP_MEMORY_SCOPE_AGENT); }
__device__ __forceinline__ unsigned xb_add(unsigned* p, unsigned v) { return __hip_atomic_fetch_add(p, v, __ATOMIC_RELAXED, __HIP_MEMORY_SCOPE_AGENT); }
__device__ __forceinline__ unsigned xb_xcc_id() { return (unsigned)__builtin_amdgcn_s_getreg((3 << 11) | 20) & 0xFu; }
#define XB_SPIN(cond, bar) do { unsigned _sp = 0; while (cond) { __builtin_amdgcn_s_sleep(1); \
    if ((++_sp & 255u) == 0u) { if (xb_ld(&(bar)[XB_TMO])) break; if (_sp > XB_SPIN_CAP) { atomicAdd(&(bar)[XB_TMO], 1u); break; } } } } while (0)

struct XcdBarrier {
    unsigned* bar; unsigned x;
    volatile LAS unsigned* st;
};

__device__ __forceinline__ XcdBarrier xcd_barrier_post(unsigned* bar, volatile LAS unsigned* st) {
    XcdBarrier b; b.bar = bar; b.x = xb_xcc_id(); b.st = st;
    if (threadIdx.x == 0) (void)xb_add(&bar[XB_XCNT(b.x)], 1u);
    return b;
}
__device__ __forceinline__ void xcd_barrier_complete(unsigned* bar, unsigned x, unsigned& nloc, unsigned& nx) {
    const unsigned G = gridDim.x * gridDim.y * gridDim.z;
    unsigned sum, cnt, mine, sp = 0u;
    for (;;) {
        sum = 0u; cnt = 0u; mine = 0u;
#pragma unroll
        for (unsigned j = 0; j < 16; ++j) { const unsigned c = xb_ld(&bar[XB_XCNT(j)]); sum += c; cnt += (c > 0u) ? 1u : 0u; mine = (j == x) ? c : mine; }
        if (sum == G) break;
        __builtin_amdgcn_s_sleep(1);
        if ((++sp & 255u) == 0u) { if (xb_ld(&bar[XB_TMO])) break; if (sp > XB_SPIN_CAP) { atomicAdd(&bar[XB_TMO], 1u); break; } }
    }
    nloc = mine > 0u ? mine : 1u; nx = cnt > 0u ? cnt : 1u;
}

__device__ __forceinline__ void xcd_barrier(const XcdBarrier& b) {
    asm volatile("s_waitcnt vmcnt(0)" ::: "memory");
    __syncthreads();
    if (threadIdx.x == 0) {
        unsigned* bar = b.bar;
        __builtin_amdgcn_s_waitcnt(0);
        unsigned nloc = b.st[0], nx = b.st[1];
        if (nloc == 0u) { xcd_barrier_complete(bar, b.x, nloc, nx); b.st[0] = nloc; b.st[1] = nx; }
        const unsigned old = xb_add(&bar[XB_XSUB(b.x)], 1u);
        const unsigned gen = old / nloc;
        if (old + 1u == (gen + 1u) * nloc) {
            __builtin_amdgcn_fence(__ATOMIC_RELEASE, "agent");
            asm volatile("s_waitcnt vmcnt(0)" ::: "memory");
            const unsigned og = xb_add(&bar[XB_TOP], 1u);
            const unsigned tg = og / nx;
            if (og + 1u == (tg + 1u) * nx) xb_add(&bar[XB_TOPGEN], 1u);
            else XB_SPIN(xb_ld(&bar[XB_TOPGEN]) == tg, bar);
            __builtin_amdgcn_fence(__ATOMIC_ACQUIRE, "agent");
            xb_add(&bar[XB_XGEN(b.x)], 1u);
            asm volatile("s_waitcnt vmcnt(0)" ::: "memory");
        } else {
            XB_SPIN(xb_ld(&bar[XB_XGEN(b.x)]) == gen, bar);
            __builtin_amdgcn_fence(__ATOMIC_ACQUIRE, "agent");
            asm volatile("s_waitcnt vmcnt(0)" ::: "memory");
        }
    }
    __syncthreads();
}

template <int MODE>
__device__ __forceinline__ void attn_tile(const LAS bf16_t* Ks, const LAS bf16_t* Vs, const bf16x8 (&qf)[2][2], f32x4 (&o)[2][4], float (&lsum)[2], float m0,
                                          const int (&tk)[2], const unsigned (&selm)[2], int j, int quad, int r16, int mask_kind, int half, int pv) {
    if (pv == 1) return;
    Ks += half * 64 * 72; Vs += half * 64;
    bf16x8 kf[4][2];
#pragma unroll
    for (int kt = 0; kt < 4; ++kt)
#pragma unroll
        for (int kb = 0; kb < 2; ++kb) kf[kt][kb] = *(const LAS bf16x8*)(Ks + (16 * kt + r16) * 72 + 32 * kb + 8 * quad);
    __builtin_amdgcn_sched_barrier(0);
    const f32x4 cinit = (f32x4){-m0, -m0, -m0, -m0};
    f32x4 s[2][4];
#pragma unroll
    for (int kt = 0; kt < 4; ++kt) {
        s[0][kt] = MFMA16(kf[kt][0], qf[0][0], cinit); s[1][kt] = MFMA16(kf[kt][0], qf[1][0], cinit);
        s[0][kt] = MFMA16(kf[kt][1], qf[0][1], s[0][kt]); s[1][kt] = MFMA16(kf[kt][1], qf[1][1], s[1][kt]);
    }
    bf16x8 vf[4][2];
#pragma unroll
    for (int dt = 0; dt < 4; ++dt)
#pragma unroll
        for (int kb2 = 0; kb2 < 2; ++kb2) {
            const u32x2 v0 = *(const LAS u32x2*)(Vs + (16 * dt + r16) * 136 + 32 * kb2 + 4 * quad);
            const u32x2 v1 = *(const LAS u32x2*)(Vs + (16 * dt + r16) * 136 + 32 * kb2 + 16 + 4 * quad);
            vf[dt][kb2] = __builtin_bit_cast(bf16x8, ((u32x4){v0.x, v0.y, v1.x, v1.y}));
        }
    __builtin_amdgcn_sched_barrier(0);
    bf16x8 pf[2][2];
#pragma unroll
    for (int rt = 0; rt < 2; ++rt) {
#pragma unroll
        for (int kt = 0; kt < 4; ++kt)
#pragma unroll
            for (int e = 0; e < 4; ++e) s[rt][kt][e] = __builtin_amdgcn_exp2f(s[rt][kt][e]);
        const bool blk = (MODE == 1) ? (((selm[rt] >> j) & 1u) != 0u) : true;
        if (mask_kind == 2) {
            const int kbase = 64 * j + 4 * quad;
            const int hi = blk ? tk[rt] : -1;
            const int lo = (MODE == 2) ? tk[rt] - 512 : -1;
#pragma unroll
            for (int kt = 0; kt < 4; ++kt)
#pragma unroll
                for (int e = 0; e < 4; ++e) {
                    const int kpos = kbase + 16 * kt + e;
                    const bool v = (kpos <= hi) && (kpos > lo);
                    s[rt][kt][e] = v ? s[rt][kt][e] : 0.f;
                }
        }
        float rs = 0.f;
#pragma unroll
        for (int kt = 0; kt < 4; ++kt) rs += (s[rt][kt][0] + s[rt][kt][1]) + (s[rt][kt][2] + s[rt][kt][3]);
        const unsigned keep = (mask_kind == 1 && !blk) ? 0u : 0xffffffffu;
        if (mask_kind == 1) rs = blk ? rs : 0.f;
        lsum[rt] += rs;
#pragma unroll
        for (int kb2 = 0; kb2 < 2; ++kb2) {
            u32x4 w;
            w.x = pk2(s[rt][2 * kb2][0], s[rt][2 * kb2][1]); w.y = pk2(s[rt][2 * kb2][2], s[rt][2 * kb2][3]);
            w.z = pk2(s[rt][2 * kb2 + 1][0], s[rt][2 * kb2 + 1][1]); w.w = pk2(s[rt][2 * kb2 + 1][2], s[rt][2 * kb2 + 1][3]);
            if (mask_kind == 1) { w.x &= keep; w.y &= keep; w.z &= keep; w.w &= keep; }
            pf[rt][kb2] = __builtin_bit_cast(bf16x8, w);
        }
    }
#pragma unroll
    for (int dt = 0; dt < 4; ++dt)
#pragma unroll
        for (int kb2 = 0; kb2 < 2; ++kb2) { o[0][dt] = MFMA16(vf[dt][kb2], pf[0][kb2], o[0][dt]); o[1][dt] = MFMA16(vf[dt][kb2], pf[1][kb2], o[1][dt]); }
}

template <int MODE>
__device__ __forceinline__ void attn_branch(const bf16_t* Kb, const bf16_t* VTb, LAS bf16_t* Ks, LAS bf16_t* Vs, const bf16x8 (&qf)[2][2], LAS f32x4* outs,
                                            const float (&gsc)[2], const int (&tk)[2], const unsigned (&selm)[2], unsigned uni, bool sel_varies, int jlo, int jhi, int tid, int quad, int r16, float m0, int pv,
                                            u32x4& kA, u32x4& vA, u32x4& kB, u32x4& vB, bool preA, bool preB, const bf16_t* nKb, const bf16_t* nVTb, int nj0, int nj1) {
    f32x4 o[2][4];
#pragma unroll
    for (int rt = 0; rt < 2; ++rt)
#pragma unroll
        for (int dt = 0; dt < 4; ++dt) o[rt][dt] = (f32x4){0.f, 0.f, 0.f, 0.f};
    float lsum[2] = {0.f, 0.f};
    const int lr = tid >> 3, lc = (tid & 7) * 8;
#define NSA_NEXT(jv) do { ++(jv); } while ((jv) <= jhi && !((uni >> (jv)) & 1u))
#define NSA_LOAD(kr, vr, jv) do { kr = *(const u32x4*)(Kb + (size_t)(64 * (jv) + lr) * 64 + lc); vr = *(const u32x4*)(VTb + (size_t)(64 * (jv) + lr) * 64 + lc); } while (0)
#define NSA_KIND(jv) ((((jv) == jhi) || (MODE == 2 && (jv) + 8 <= jhi)) ? 2 : ((MODE == 1 && sel_varies) ? 1 : 0))
    int j0 = jlo - 1; NSA_NEXT(j0);
    int j1 = j0; NSA_NEXT(j1);
    if (j0 <= jhi && !preA) NSA_LOAD(kA, vA, j0);
    if (j1 <= jhi && !preB) NSA_LOAD(kB, vB, j1);
    while (j0 <= jhi) {
        int j2 = j1; NSA_NEXT(j2);
        int j3 = j2; NSA_NEXT(j3);
        LDS_BARRIER();
        *(LAS u32x4*)(Ks + lr * 72 + lc) = kA; *(LAS u32x4*)(Vs + lr * 136 + lc) = vA;
        *(LAS u32x4*)(Ks + (64 + lr) * 72 + lc) = kB; *(LAS u32x4*)(Vs + lr * 136 + 64 + lc) = vB;
        if (j2 <= jhi) { NSA_LOAD(kA, vA, j2); if (j3 <= jhi) NSA_LOAD(kB, vB, j3); }
        else if (nKb) {
            kA = *(const u32x4*)(nKb + (size_t)(64 * nj0 + lr) * 64 + lc); vA = *(const u32x4*)(nVTb + (size_t)(64 * nj0 + lr) * 64 + lc);
            if (nj1 >= 0) { kB = *(const u32x4*)(nKb + (size_t)(64 * nj1 + lr) * 64 + lc); vB = *(const u32x4*)(nVTb + (size_t)(64 * nj1 + lr) * 64 + lc); }
        }
        LDS_BARRIER();
        attn_tile<MODE>(Ks, Vs, qf, o, lsum, m0, tk, selm, j0, quad, r16, NSA_KIND(j0), 0, pv);
        if (j1 <= jhi) attn_tile<MODE>(Ks, Vs, qf, o, lsum, m0, tk, selm, j1, quad, r16, NSA_KIND(j1), 1, pv);
        j0 = j2; j1 = j3;
    }
#undef NSA_KIND
#undef NSA_NEXT
#undef NSA_LOAD
#pragma unroll
    for (int rt = 0; rt < 2; ++rt) {
        float lr_ = lsum[rt]; lr_ += __shfl_xor(lr_, 16); lr_ += __shfl_xor(lr_, 32);
        const float inv = lr_ > 0.f ? gsc[rt] / lr_ : 0.f;
#pragma unroll
        for (int dt = 0; dt < 4; ++dt) outs[(rt * 4 + dt) * 64] = outs[(rt * 4 + dt) * 64] + o[rt][dt] * inv;
    }
}

__device__ __forceinline__ void nsa_unit(const Params& p, int l, int item, LAS unsigned char* lds, int tid, int wave, int lane, int pv) {
    const int qt = 31 - (item & 31), bg = item >> 5, b = bg >> 1, g = bg & 1, t0 = qt * 64;
    const int quad = lane >> 4, r16 = lane & 15, hh = lane & 3;
    unsigned char* ws = p.ws; unsigned char* aux = (unsigned char*)p.out;
    const bf16_t* PROJ = (const bf16_t*)(ws + WS_PROJ);
    LAS bf16_t* Ks = (LAS bf16_t*)lds;
    LAS bf16_t* Vs = (LAS bf16_t*)(lds + 18432);
    LAS float* IMP = (LAS float*)(lds + 35840);
    LAS unsigned* SEL = (LAS unsigned*)(lds + 44288);
    int tk[2]; tk[0] = t0 + 8 * wave + (r16 >> 2); tk[1] = tk[0] + 4;
    bf16x8 qf[2][2];
    {
        const bf16_t* Qb = (const bf16_t*)(ws + WS_QN) + ((size_t)bg * T + t0) * 256;
#pragma unroll
        for (int rt = 0; rt < 2; ++rt)
#pragma unroll
            for (int kb = 0; kb < 2; ++kb) qf[rt][kb] = *(const bf16x8*)(Qb + (size_t)(32 * wave + 16 * rt + r16) * 64 + 32 * kb + 8 * quad);
    }
    float gt[3][2];
#pragma unroll
    for (int rt = 0; rt < 2; ++rt)
#pragma unroll
        for (int br = 0; br < 3; ++br) { const float z = bf2f(PROJ[(size_t)(b * T + tk[rt]) * NPROJ + C_GT + (g * 4 + hh) * 3 + br]); gt[br][rt] = 1.f / (1.f + __expf(-z)); }
    const float* M0T = (const float*)(ws + WS_CTL + 24576) + 4 * l;
    const float m0c = M0T[0], m0s = M0T[1], m0w = M0T[2];
    f32x4 out[2][4];
#pragma unroll
    for (int rt = 0; rt < 2; ++rt)
#pragma unroll
        for (int dt = 0; dt < 4; ++dt) out[rt][dt] = (f32x4){0.f, 0.f, 0.f, 0.f};
    const bf16_t* KSb = (const bf16_t*)(aux + AX_KS) + (size_t)bg * T * 64; const bf16_t* VSTb = (const bf16_t*)(aux + AX_VST) + (size_t)bg * 64 * T;
    const bf16_t* KWb = (const bf16_t*)(aux + AX_KW) + (size_t)bg * T * 64; const bf16_t* VWTb = (const bf16_t*)(aux + AX_VWT) + (size_t)bg * 64 * T;
    u32x4 kA, vA, kB = (u32x4){0u, 0u, 0u, 0u}, vB = kB;
    kA = *(const u32x4*)(KSb + (size_t)(tid >> 3) * 64 + (tid & 7) * 8); vA = *(const u32x4*)(VSTb + (size_t)(tid >> 3) * 64 + (tid & 7) * 8);
    {
        const bf16_t* KCb = (const bf16_t*)(aux + AX_KC) + (size_t)bg * 128 * 64;
        const bf16_t* VCb = (const bf16_t*)(aux + AX_VCT) + (size_t)bg * 64 * 128;
#pragma unroll
        for (int k = 0; k < 2; ++k) {
            const int c = tid + 512 * k;
            *(LAS u32x4*)(Ks + (c >> 3) * 72 + (c & 7) * 8) = *(const u32x4*)(KCb + (size_t)(c >> 3) * 64 + (c & 7) * 8);
            *(LAS u32x4*)(Vs + (c >> 4) * 136 + (c & 15) * 8) = *(const u32x4*)(VCb + (size_t)(c >> 4) * 128 + (c & 15) * 8);
        }
        __syncthreads();
        if (qt < 16) {
#pragma unroll
        for (int rt = 0; rt < 2; ++rt) {
            f32x4 s[4];
#pragma unroll
            for (int kt = 0; kt < 4; ++kt) {
                s[kt] = (f32x4){0.f, 0.f, 0.f, 0.f};
                {
#pragma unroll
                    for (int kb = 0; kb < 2; ++kb) { const bf16x8 a = *(const LAS bf16x8*)(Ks + (16 * kt + r16) * 72 + 32 * kb + 8 * quad); s[kt] = MFMA16(a, qf[rt][kb], s[kt]); }
                }
            }
            float rs = 0.f;
#pragma unroll
            for (int kt = 0; kt < 4; ++kt) {
                {
#pragma unroll
                    for (int e = 0; e < 4; ++e) { const int n = 16 * kt + 4 * quad + e; const bool v = (16 * n + 31 <= tk[rt]); const float pv = v ? __builtin_amdgcn_exp2f(s[kt][e] - m0c) : 0.f; s[kt][e] = pv; rs += pv; }
                }
            }
            rs += __shfl_xor(rs, 16); rs += __shfl_xor(rs, 32);
            const float inv = rs > 0.f ? 1.f / rs : 0.f;
#pragma unroll
            for (int kt = 0; kt < 4; ++kt) s[kt] = s[kt] * inv;
            const float gs = gt[0][rt];
#pragma unroll
            for (int dt = 0; dt < 4; ++dt) {
                f32x4 oc = (f32x4){0.f, 0.f, 0.f, 0.f};
#pragma unroll
                for (int kb2 = 0; kb2 < 2; ++kb2) {
                    u32x4 w;
                    w.x = pk2(s[2 * kb2][0], s[2 * kb2][1]); w.y = pk2(s[2 * kb2][2], s[2 * kb2][3]);
                    w.z = pk2(s[2 * kb2 + 1][0], s[2 * kb2 + 1][1]); w.w = pk2(s[2 * kb2 + 1][2], s[2 * kb2 + 1][3]);
                    const bf16x8 pfr = __builtin_bit_cast(bf16x8, w);
                    const u32x2 v0 = *(const LAS u32x2*)(Vs + (16 * dt + r16) * 136 + 32 * kb2 + 4 * quad);
                    const u32x2 v1 = *(const LAS u32x2*)(Vs + (16 * dt + r16) * 136 + 32 * kb2 + 16 + 4 * quad);
                    const bf16x8 vf = __builtin_bit_cast(bf16x8, ((u32x4){v0.x, v0.y, v1.x, v1.y}));
                    oc = MFMA16(vf, pfr, oc);
                }
                out[rt][dt] = out[rt][dt] + oc * gs;
            }
            asm volatile("" ::: "memory");
        }
        } else {
#pragma unroll
        for (int rt = 0; rt < 2; ++rt) {
            f32x4 s[8];
#pragma unroll
            for (int kt = 0; kt < 8; ++kt) {
                s[kt] = (f32x4){0.f, 0.f, 0.f, 0.f};
                {
#pragma unroll
                    for (int kb = 0; kb < 2; ++kb) { const bf16x8 a = *(const LAS bf16x8*)(Ks + (16 * kt + r16) * 72 + 32 * kb + 8 * quad); s[kt] = MFMA16(a, qf[rt][kb], s[kt]); }
                }
            }
            float rs = 0.f;
#pragma unroll
            for (int kt = 0; kt < 8; ++kt) {
                {
#pragma unroll
                    for (int e = 0; e < 4; ++e) { const int n = 16 * kt + 4 * quad + e; const bool v = (16 * n + 31 <= tk[rt]); const float pv = v ? __builtin_amdgcn_exp2f(s[kt][e] - m0c) : 0.f; s[kt][e] = pv; rs += pv; }
                }
            }
            rs += __shfl_xor(rs, 16); rs += __shfl_xor(rs, 32);
            const float inv = rs > 0.f ? 1.f / rs : 0.f;
#pragma unroll
            for (int kt = 0; kt < 8; ++kt) s[kt] = s[kt] * inv;
            if (qt >= 16) {
                float sh[8];
#pragma unroll
                for (int kt = 0; kt < 8; ++kt) sh[kt] = __shfl(s[kt][3], (lane + 48) & 63);
#pragma unroll
                for (int kt = 0; kt < 8; ++kt) {
                    const float nb = quad ? sh[kt] : (kt ? sh[kt > 0 ? kt - 1 : 0] : 0.f);
                    float im = (s[kt][0] + s[kt][1]) + (s[kt][2] + s[kt][3]) + nb;
                    im += __shfl_xor(im, 1); im += __shfl_xor(im, 2);
                    if (hh == 0) IMP[(8 * wave + 4 * rt + (r16 >> 2)) * 33 + 4 * kt + quad] = im;
                }
            }
            const float gs = gt[0][rt];
#pragma unroll
            for (int dt = 0; dt < 4; ++dt) {
                f32x4 oc = (f32x4){0.f, 0.f, 0.f, 0.f};
#pragma unroll
                for (int kb2 = 0; kb2 < 4; ++kb2) {
                    u32x4 w;
                    w.x = pk2(s[2 * kb2][0], s[2 * kb2][1]); w.y = pk2(s[2 * kb2][2], s[2 * kb2][3]);
                    w.z = pk2(s[2 * kb2 + 1][0], s[2 * kb2 + 1][1]); w.w = pk2(s[2 * kb2 + 1][2], s[2 * kb2 + 1][3]);
                    const bf16x8 pfr = __builtin_bit_cast(bf16x8, w);
                    const u32x2 v0 = *(const LAS u32x2*)(Vs + (16 * dt + r16) * 136 + 32 * kb2 + 4 * quad);
                    const u32x2 v1 = *(const LAS u32x2*)(Vs + (16 * dt + r16) * 136 + 32 * kb2 + 16 + 4 * quad);
                    const bf16x8 vf = __builtin_bit_cast(bf16x8, ((u32x4){v0.x, v0.y, v1.x, v1.y}));
                    oc = MFMA16(vf, pfr, oc);
                }
                out[rt][dt] = out[rt][dt] + oc * gs;
            }
            asm volatile("" ::: "memory");
        }
        }
    }
    LAS f32x4* outs = (LAS f32x4*)(lds + 49152) + wave * 512 + lane;
#pragma unroll
    for (int rt = 0; rt < 2; ++rt)
#pragma unroll
        for (int dt = 0; dt < 4; ++dt) outs[(rt * 4 + dt) * 64] = out[rt][dt];
    unsigned selm[2], uni;
    if (qt >= 16) {
        __syncthreads();
#pragma unroll
        for (int ps = 0; ps < 4; ++ps) {
            const int token = 16 * ps + (tid >> 5), j = tid & 31;
            const float my = IMP[token * 33 + j];
            int rank = 0;
            for (int jj = 1; jj <= qt - 2; ++jj) { const float ov = IMP[token * 33 + jj]; rank += ((ov > my) || (ov == my && jj < j)) ? 1 : 0; }
            const bool sel = (j == 0) || (j == qt) || (j == qt - 1) || (j >= 1 && j <= qt - 2 && rank < 13);
            const unsigned long long bal = __ballot(sel);
            if ((lane & 31) == 0) SEL[token] = (lane < 32) ? (unsigned)bal : (unsigned)(bal >> 32);
        }
        __syncthreads();
        selm[0] = SEL[8 * wave + (r16 >> 2)]; selm[1] = SEL[8 * wave + 4 + (r16 >> 2)];
        uni = 0u;
        for (int k = 0; k < 64; ++k) uni |= SEL[k];
        uni = __builtin_amdgcn_readfirstlane(uni);
    } else { selm[0] = selm[1] = uni = (2u << qt) - 1u; }
    {
        const int wlo = qt > 8 ? qt - 8 : 0;
        {
            const float gsc[2] = {gt[1][0], gt[1][1]};
            attn_branch<1>(KSb, VSTb, Ks, Vs, qf, outs, gsc, tk, selm, uni, qt >= 16, 0, qt, tid, quad, r16, m0s, pv,
                           kA, vA, kB, vB, true, false, KWb, VWTb, wlo, wlo + 1 <= qt ? wlo + 1 : -1);
        }
        {
            const float gsc[2] = {gt[2][0], gt[2][1]};
            attn_branch<2>(KWb, VWTb, Ks, Vs, qf, outs, gsc, tk, selm, 0xffffffffu, false, wlo, qt, tid, quad, r16, m0w, pv,
                           kA, vA, kB, vB, true, true, (const bf16_t*)nullptr, (const bf16_t*)nullptr, 0, -1);
        }
    }
    {
        bf16_t* MIX = (bf16_t*)(ws + WS_MIX);
#pragma unroll
        for (int rt = 0; rt < 2; ++rt)
#pragma unroll
            for (int dt = 0; dt < 4; ++dt) {
                const f32x4 ov = outs[(rt * 4 + dt) * 64];
                u32x2 w; w.x = pk2(ov[0], ov[1]); w.y = pk2(ov[2], ov[3]);
                if (NSA_ZERO) { w.x = 0u; w.y = 0u; }
                *(u32x2*)(MIX + (size_t)(b * T + tk[rt]) * DM + 512 + (g * 4 + hh) * 64 + 16 * dt + 4 * quad) = w;
            }
    }
    LDS_BARRIER();
}

#ifndef NSA_PV
#define NSA_PV 0
#endif
#ifndef PROBE_NSA2
#define PROBE_NSA2 0
#endif
#ifndef STAGGER_US
#define STAGGER_US 0
#endif
#ifndef PROBE_HG2
#define PROBE_HG2 0
#endif
#ifndef PROBE_DUP
#define PROBE_DUP 0
#endif
#ifndef NAIVE_MASK
#define NAIVE_MASK 0
#endif
#ifndef HG_NAIVE
#define HG_NAIVE 0
#endif
#ifndef PHMASK
#define PHMASK 0x1ff
#endif
constexpr int N_PHASES = 1 + 8 * DEPTH;
__global__ void __launch_bounds__(NTHREADS) fwd_kernel(Params p) {
    extern __shared__ __attribute__((aligned(16))) unsigned char lds_raw[];
    LAS unsigned char* lds = (LAS unsigned char*)lds_raw;
    const int G = gridDim.x, NGW = G * 8;
    unsigned char* ws = p.ws;
    if (threadIdx.x < 2) ((LAS unsigned*)(lds + LDS_BYTES - 32))[threadIdx.x] = 0u;
    __syncthreads();
    const XcdBarrier xbar = xcd_barrier_post((unsigned*)(ws + WS_XBAR), (volatile LAS unsigned*)(lds + LDS_BYTES - 32));
    for (int ph = p.ph_lo; ph < p.ph_hi; ++ph) {
        if (ph > p.ph_lo) {
            if (p.ph_hi < 0) cg::this_grid().sync();
            xcd_barrier(xbar);
        }
        const int code = p.prog[ph], l = code >> 4, sub = code & 15;
        int tid = threadIdx.x; asm volatile("" : "+v"(tid));
        int bid = blockIdx.x; asm volatile("" : "+s"(bid));
        const int lane = tid & 63, wave = __builtin_amdgcn_readfirstlane(tid >> 6), gw = bid * 8 + wave;
        if (sub == 8) { prologue_phase(p, lds, gw, NGW, wave, lane); continue; }
        if (sub == 0 && (PHMASK & 2)) {
            pg8::Gemm g{(const bf16_t*)(ws + WS_XN), (const bf16_t*)(ws + WS_WIN) + (size_t)l * NPROJ * DM, M, NPROJ, DM};
            pg8::StaticOrder S; S.init(M, NPROJ, G, bid);
            EpiProj E{(bf16_t*)(ws + WS_PROJ), (float*)(ws + WS_LOGF), (const float*)(ws + WS_CTL + 16384) + l * 512, (const float*)(ws + WS_RS) + (size_t)(2 * l) * M};
            pg8::gemm_phase<EpiProj, pg8::StaticOrder, true, true>(lds, g, S, E, tid);
        } else if (sub == 1 && (PHMASK & 4)) {
            for (int it = bid; it < 256 + 1024; it += G) {
                int t2 = tid; asm volatile("" : "+v"(t2));
                const int l2 = t2 & 63, w2 = __builtin_amdgcn_readfirstlane(t2 >> 6);
                if (it < 256) compress_item(p, l, it, lds, t2, w2, l2);
                else prep_item(p, l, it - 256, lds, t2, w2, l2);
            }
        } else if ((sub == 2 || sub == 9) && (PHMASK & 8)) {
            unsigned* qc = (unsigned*)(ws + WS_QCTR) + (size_t)ph * 8 * 64;
            const unsigned xcc = (unsigned)__builtin_amdgcn_s_getreg((3 << 11) | 20) & 7u;
            LAS int* qslot = (LAS int*)(lds + LDS_BYTES - 16);
#define Q_POP(dst) do { int it_ = 1 << 30; \
                for (unsigned k_ = 0; k_ < 8u; ++k_) { const unsigned x_ = (xcc + k_) & 7u; unsigned* c_ = qc + 64 * x_; \
                    if (__hip_atomic_load(c_, __ATOMIC_RELAXED, __HIP_MEMORY_SCOPE_AGENT) >= 272u) continue; \
                    const unsigned i_ = atomicAdd(c_, 1u); if (i_ >= 272u) continue; \
                    it_ = (i_ < 16u) ? (int)(x_ * 16u + i_) : 128 + (int)((x_ + 8u * ((i_ - 16u) >> 5)) * 32u + ((i_ - 16u) & 31u)); break; } \
                dst = it_; } while (0)
            if (tid == 0) { int it0; Q_POP(it0); *qslot = it0; }
            __syncthreads();
            for (;;) {
                const int item = __builtin_amdgcn_readfirstlane(*qslot);
                LDS_BARRIER();
                if (item >= 128 + 2048) break;
                int nxt = 0;
                if (tid == 0) Q_POP(nxt);
                int t2 = tid; asm volatile("" : "+v"(t2));
                const int l2 = t2 & 63, w2 = __builtin_amdgcn_readfirstlane(t2 >> 6);
                if (item < 128) hgrn_item(p, l, item, lds, t2, w2, l2);
                else nsa_unit(p, l, item - 128, lds, t2, w2, l2, 0);
                if (tid == 0) *qslot = nxt;
                LDS_BARRIER();
            }
#undef Q_POP
        } else if ((sub == 3 || sub == 6) && (PHMASK & 16)) {
            const bool ffn = (sub == 6);
            pg8::Gemm g{ffn ? (const bf16_t*)(ws + WS_PROJ) : (const bf16_t*)(ws + WS_MIX),
                        ffn ? (const bf16_t*)(ws + WS_WFFO) + (size_t)l * DM * DFF : (const bf16_t*)(ws + WS_WOUT) + (size_t)l * DM * DM, M, DM, ffn ? DFF : DM};
            pg8::StaticOrder S; S.init(M, DM, G, bid);
            const bool last = ffn && (l + 1 == DEPTH);
            EpiRes E{(bf16_t*)(ws + WS_XN), last ? p.out : (float*)nullptr, (float*)(ws + WS_RS) + (size_t)(2 * l + (ffn ? 2 : 1)) * M};
            if (STAGGER_US && (bid & 8)) { const unsigned long long t0 = __builtin_amdgcn_s_memrealtime(); while (__builtin_amdgcn_s_memrealtime() - t0 < (unsigned long long)(STAGGER_US * 100)) __builtin_amdgcn_s_sleep(32); }
            pg8::gemm_phase<EpiRes, pg8::StaticOrder, true, true>(lds, g, S, E, tid);
        } else if (sub == 5 && (PHMASK & 64)) {
            pg8::Gemm g{(const bf16_t*)(ws + WS_XN), (const bf16_t*)(ws + WS_WFFI) + (size_t)l * 2 * DFF * DM, M, 2 * DFF, DM};
            pg8::StaticOrder S; S.init(M, 2 * DFF, G, bid);
            EpiSwiGLU E{(bf16_t*)(ws + WS_PROJ), (const float*)(ws + WS_RS) + (size_t)(2 * l + 1) * M};
            pg8::gemm_phase<EpiSwiGLU, pg8::StaticOrder, true, true>(lds, g, S, E, tid);
        }
    }
}

#ifndef MK_COOP
#define MK_COOP 1
#endif
extern "C" void kernel_launch(void* const* d_in, const int* in_sizes, int n_in, void* d_out, int out_size, void* d_ws, size_t ws_size, hipStream_t stream) {
    static int grid = 0;
    if (grid == 0) {
        if (n_in != 17 || out_size != M * DM || ws_size < WS_END) { fprintf(stderr, "kernel_launch: unexpected shapes (n_in %d out %d ws %zu)\n", n_in, out_size, ws_size); grid = -1; return; }
        int dev = 0, cus = 0, per_cu = 0;
        (void)hipGetDevice(&dev); (void)hipDeviceGetAttribute(&cus, hipDeviceAttributeMultiprocessorCount, dev);
        if (hipFuncSetAttribute((const void*)fwd_kernel, hipFuncAttributeMaxDynamicSharedMemorySize, LDS_BYTES) != hipSuccess) { fprintf(stderr, "kernel_launch: hipFuncSetAttribute failed\n"); grid = -1; return; }
        if (hipOccupancyMaxActiveBlocksPerMultiprocessor(&per_cu, (const void*)fwd_kernel, NTHREADS, LDS_BYTES) != hipSuccess || per_cu < 1) { fprintf(stderr, "kernel_launch: occupancy query says %d\n", per_cu); per_cu = 1; }
        (void)hipGetLastError();
        grid = cus > 0 ? cus : 256;
    }
    if (grid < 0) return;
    if (hipMemsetAsync((char*)d_ws + WS_XBAR, 0, 3456 * sizeof(unsigned), stream) != hipSuccess) { fprintf(stderr, "kernel_launch: hipMemsetAsync of the barrier words failed\n"); return; }
    Params p{};
    for (int i = 0; i < 17; ++i) p.in[i] = (const float*)d_in[i];
    p.out = (float*)d_out; p.ws = (unsigned char*)d_ws;
    int np = 0;
    auto add = [&](int l, int sub, int dupbit) { p.prog[np++] = (unsigned char)((l << 4) | sub); if (PROBE_DUP & dupbit) p.prog[np++] = (unsigned char)((l << 4) | sub); };
    add(0, 8, 1);
    for (int l = 0; l < DEPTH; ++l) { add(l, 0, 0); add(l, 1, 2); if (PROBE_NSA2) add(l, 9, 0); add(l, 2, 4); add(l, 3, 0); add(l, 5, 0); add(l, 6, 0); }
    const int N_PH = np;
#if MK_COOP
    p.ph_lo = 0; p.ph_hi = N_PH;
    void* args[] = {&p};
    hipError_t e = hipLaunchCooperativeKernel((const void*)fwd_kernel, dim3(grid), dim3(NTHREADS), args, LDS_BYTES, stream);
    if (e != hipSuccess) fprintf(stderr, "cooperative launch failed: %s (grid %d)\n", hipGetErrorString(e), grid);
#else
    for (int ph = 0; ph < N_PH; ++ph) {
        p.ph_lo = ph; p.ph_hi = ph + 1;
        hipLaunchKernelGGL(fwd_kernel, dim3(grid), dim3(NTHREADS), LDS_BYTES, stream, p);
    }
#endif
}
```
